# Optimizing an MI355X kernel written in HIP

```python
import math
import jax, jax.numpy as jnp
from jax import lax
import numpy as np

D_MODEL = 1024
BATCH = 32
SEQ = 2048
DEPTH = 2

D_RWKV = D_MODEL // 2
HEAD_SIZE = 64
N_HEADS_RWKV = D_RWKV // HEAD_SIZE
D_HYENA = D_MODEL - D_RWKV
HYENA_GROUPS = 8
DECAY_LORA = 64
AAA_LORA = 64
GATE_LORA = 160
HYENA_EMB = 33
HYENA_BANDS = (HYENA_EMB - 1) // 2
FILTER_ORDER = 64
N_INNER = 2
FAST_DECAY_PCT = 0.3
SLOW_DECAY_PCT = 1.5
DECAY_TARGET = 1e-2
FILTER_OUT_SCALE = 0.1
D_FF = 2816
ALPHA = (2 * DEPTH) ** 0.25
BETA = (8 * DEPTH) ** -0.25
LN_EPS = 1e-5
GN_EPS = 64e-5
N_MOD = 6
RWKV_SPLITS = (D_RWKV, 2 * D_RWKV, 3 * D_RWKV, 3 * D_RWKV + 2 * DECAY_LORA,
               3 * D_RWKV + 2 * DECAY_LORA + 2 * AAA_LORA)
RWKV_COLS = 3 * D_RWKV + 2 * DECAY_LORA + 2 * AAA_LORA + GATE_LORA
HYENA_COLS = 3 * D_HYENA
P_IN = RWKV_COLS + HYENA_COLS

kernel_name = 'hybrid_rwkv7_hyena_deepnorm_adaln_encoder'

F32 = jnp.float32


def _ln(x, g=None, b=None):
    xf = x.astype(F32)
    mu = jnp.mean(xf, -1, keepdims=True)
    var = jnp.mean(jnp.square(xf - mu), -1, keepdims=True)
    y = (xf - mu) * lax.rsqrt(var + LN_EPS)
    if g is not None:
        y = y * g + b
    return y.astype(x.dtype)


def _shift_prev(p):
    return jnp.pad(p, ((0, 0), (1, 0), (0, 0)))[:, :-1]


def _shift_next(p):
    return jnp.pad(p, ((0, 0), (0, 1), (0, 0)))[:, 1:]


def _dwconv3(p, w, b):
    return w[0] * _shift_prev(p) + w[1] * p + w[2] * _shift_next(p) + b


def _bidir_delta_scan(r, w, k, v, z, b):
    B, T, _ = r.shape
    H, N = N_HEADS_RWKV, HEAD_SIZE

    def both(u):
        return jnp.stack([u, u[:, ::-1]], 0)

    def rev(u):
        return jnp.stack([u[0], u[1][:, ::-1]], 0)

    def tm(u):
        return jnp.transpose(u.astype(F32).reshape(2, B, T, H, N), (2, 0, 1, 3, 4))

    xs = (tm(both(r)), tm(rev(w)), tm(rev(k)), tm(both(v)), tm(both(z)), tm(rev(b)))

    def step(S, inp):
        r_t, w_t, k_t, v_t, z_t, b_t = inp
        Sz = jnp.einsum('dbhvk,dbhk->dbhv', S, z_t)
        S = S * w_t[..., None, :] + Sz[..., :, None] * b_t[..., None, :] + v_t[..., :, None] * k_t[..., None, :]
        return S, jnp.einsum('dbhvk,dbhk->dbhv', S, r_t)

    S0 = jnp.zeros((2, B, H, N, N), F32)
    _, ys = lax.scan(step, S0, xs)
    return jnp.transpose(ys[:, 0] + ys[::-1, 1], (1, 0, 2, 3))


def _rwkv7_time_mix(ps, w0, w_up, a0, a_up, g_up, k_k, k_a, r_k, gn_w, gn_b):
    B, T, _ = ps.shape
    H, N = N_HEADS_RWKV, HEAD_SIZE
    r, k, v, wd, ad, gd = jnp.split(ps, RWKV_SPLITS, axis=-1)
    wd = wd.reshape(B, T, 2, DECAY_LORA)
    ad = ad.reshape(B, T, 2, AAA_LORA)
    w_log = -jax.nn.softplus(-(w0[:, None, None, :] + jnp.einsum('btdr,drc->dbtc', jnp.tanh(wd), w_up))) - 0.5
    decay = jnp.exp(-jnp.exp(w_log.astype(F32)))
    a = jax.nn.sigmoid(a0[:, None, None, :] + jnp.einsum('btdr,drc->dbtc', ad, a_up))
    g = jax.nn.sigmoid(gd) @ g_up
    kk = (k * k_k).reshape(B, T, H, N).astype(F32)
    kk = kk / jnp.maximum(jnp.sqrt(jnp.sum(kk * kk, -1, keepdims=True)), 1e-12)
    kk = kk.reshape(B, T, D_RWKV)
    k_dir = k[None] * (1 + (a - 1) * k_a)
    b_dir = kk[None] * a
    y = _bidir_delta_scan(r, decay, k_dir, v, -kk, b_dir)
    mu = jnp.mean(y, -1, keepdims=True)
    var = jnp.mean(jnp.square(y - mu), -1, keepdims=True)
    y = ((y - mu) * lax.rsqrt(var + GN_EPS)).reshape(B, T, D_RWKV) * gn_w + gn_b
    k_sum = k_dir.sum(0).reshape(B, T, H, N)
    bonus = jnp.sum(r.reshape(B, T, H, N) * k_sum * r_k, -1, keepdims=True) * v.reshape(B, T, H, N)
    y = y + bonus.reshape(B, T, D_RWKV).astype(F32)
    return (y * g).astype(ps.dtype)


def _hyena_filters(L, w1, b1, w_in, b_in, freq, w_out):
    t = jnp.linspace(0.0, 1.0, L, dtype=F32)[:, None]
    pos = jnp.arange(L, dtype=F32)[:, None]
    f = jnp.linspace(1e-4, HYENA_BANDS - 1, HYENA_BANDS, dtype=F32)[None, :]
    ang = (2.0 * math.pi / L) * pos * f
    z = jnp.concatenate([t, jnp.cos(ang), -jnp.sin(ang)], -1)
    freq = freq.astype(F32)
    h = jnp.sin(freq * (z @ w1.astype(F32) + b1.astype(F32)))
    for i in range(N_INNER):
        h = jnp.sin(freq * (h @ w_in[i].astype(F32) + b_in[i].astype(F32)))
    h = (h @ w_out.astype(F32)).reshape(L, 2, D_HYENA)
    max_decay = math.log(DECAY_TARGET) / FAST_DECAY_PCT
    min_decay = math.log(DECAY_TARGET) / SLOW_DECAY_PCT
    deltas = jnp.linspace(min_decay, max_decay, D_HYENA, dtype=F32)
    h = h * jnp.exp(-t[:, :, None] * jnp.abs(deltas))
    return h[:, 0], h[:, 1]


def _bidir_fftconv(u, h_fwd, h_bwd, bias):
    L = u.shape[1]
    kern = jnp.concatenate([h_fwd, jnp.zeros_like(h_fwd[:1]), h_bwd[1:][::-1]], 0)
    k_f = jnp.fft.rfft(kern, n=2 * L, axis=0)
    u_f = jnp.fft.rfft(u.astype(F32), n=2 * L, axis=1)
    y = jnp.fft.irfft(u_f * k_f[None], n=2 * L, axis=1)[:, :L]
    return (y + u.astype(F32) * bias.astype(F32)).astype(u.dtype)


def _hyena_mix(q, w1, b1, w_in, b_in, freq, w_out, bias):
    x0, x1, hv = jnp.split(q, 3, axis=-1)
    h_fwd, h_bwd = _hyena_filters(q.shape[1], w1, b1, w_in, b_in, freq, w_out)
    return x0 * _bidir_fftconv(x1 * hv, h_fwd, h_bwd, bias)


def _conv_ffn(h, w_up, conv_w, conv_b, w_down):
    ua, ug = jnp.split(h @ w_up, 2, axis=-1)
    ug = _dwconv3(ug, conv_w, conv_b)
    return (jax.nn.gelu(ug, approximate=False) * ua) @ w_down


def setup_inputs(seed: int = 0) -> dict:
    key = jax.random.key(seed)
    ks = iter(jax.random.split(key, 48))

    def nrm(shape, std):
        return std * jax.random.normal(next(ks), shape, F32)

    Lr, D = DEPTH, D_MODEL
    n = jnp.arange(D_RWKV, dtype=F32) / (D_RWKV - 1)
    return {
        'x': nrm((BATCH, SEQ, D), 1.0),
        'c': nrm((BATCH, D), 1.0),
        'w_ada': nrm((D, N_MOD * D), 0.1 * D ** -0.5),
        'b_ada': nrm((N_MOD * D,), 0.02),
        'ada_table': nrm((Lr, N_MOD, D), 0.02),
        'w_in': nrm((Lr, D, P_IN), D ** -0.5),
        'mu_prev': jax.random.uniform(next(ks), (Lr, RWKV_COLS), F32, 0.05, 0.45),
        'mu_next': jax.random.uniform(next(ks), (Lr, RWKV_COLS), F32, 0.05, 0.45),
        'hy_conv_w': nrm((Lr, 3, HYENA_COLS), 3 ** -0.5),
        'hy_conv_b': nrm((Lr, HYENA_COLS), 0.02),
        'w0': (-6.0 + 5.0 * n ** 0.9)[None, None, :] + nrm((Lr, 2, D_RWKV), 0.1),
        'w_up': nrm((Lr, 2, DECAY_LORA, D_RWKV), 0.5 * DECAY_LORA ** -0.5),
        'a0': nrm((Lr, 2, D_RWKV), 0.1),
        'a_up': nrm((Lr, 2, AAA_LORA, D_RWKV), 0.5 * AAA_LORA ** -0.5),
        'g_up': nrm((Lr, GATE_LORA, D_RWKV), GATE_LORA ** -0.5),
        'k_k': 0.85 + nrm((Lr, D_RWKV), 0.02),
        'k_a': 1.0 + nrm((Lr, D_RWKV), 0.02),
        'r_k': nrm((Lr, N_HEADS_RWKV, HEAD_SIZE), 0.1),
        'gn_w': 1.0 + nrm((Lr, D_RWKV), 0.02),
        'gn_b': nrm((Lr, D_RWKV), 0.02),
        'flt_w1': nrm((Lr, HYENA_EMB, FILTER_ORDER), HYENA_EMB ** -0.5),
        'flt_b1': nrm((Lr, FILTER_ORDER), 0.02),
        'flt_w_in': nrm((Lr, N_INNER, FILTER_ORDER, FILTER_ORDER), FILTER_ORDER ** -0.5),
        'flt_b_in': nrm((Lr, N_INNER, FILTER_ORDER), 0.02),
        'flt_freq': 1.0 + nrm((Lr, FILTER_ORDER), 0.02),
        'flt_w_out': nrm((Lr, FILTER_ORDER, 2 * D_HYENA), FILTER_OUT_SCALE * FILTER_ORDER ** -0.5),
        'hy_bias': nrm((Lr, D_HYENA), 0.1),
        'w_out': nrm((Lr, D, D), BETA * D ** -0.5),
        'ln_mix_g': 1.0 + nrm((Lr, D), 0.02),
        'ln_mix_b': nrm((Lr, D), 0.02),
        'ffn_up': nrm((Lr, D, 2 * D_FF), D ** -0.5),
        'ffn_conv_w': nrm((Lr, 3, D_FF), 3 ** -0.5),
        'ffn_conv_b': nrm((Lr, D_FF), 0.02),
        'ffn_down': nrm((Lr, D_FF, D), BETA * D_FF ** -0.5),
        'ln_ffn_g': 1.0 + nrm((Lr, D), 0.02),
        'ln_ffn_b': nrm((Lr, D), 0.02),
    }


def reference(x, c, w_ada, b_ada, ada_table, w_in, mu_prev, mu_next, hy_conv_w, hy_conv_b,
              w0, w_up, a0, a_up, g_up, k_k, k_a, r_k, gn_w, gn_b,
              flt_w1, flt_b1, flt_w_in, flt_b_in, flt_freq, flt_w_out, hy_bias,
              w_out, ln_mix_g, ln_mix_b, ffn_up, ffn_conv_w, ffn_conv_b, ffn_down,
              ln_ffn_g, ln_ffn_b):
    B = x.shape[0]
    base = (jax.nn.silu(c) @ w_ada + b_ada).reshape(B, N_MOD, D_MODEL)
    for l in range(DEPTH):
        mod = base + ada_table[l]
        sh_m, sc_m, gt_m, sh_f, sc_f, gt_f = [mod[:, i, None, :] for i in range(N_MOD)]
        h = _ln(x) * (1 + sc_m) + sh_m
        p = h @ w_in[l]
        ps = p[..., :RWKV_COLS]
        ps = ps + mu_prev[l] * (_shift_prev(ps) - ps) + mu_next[l] * (_shift_next(ps) - ps)
        y_rwkv = _rwkv7_time_mix(ps, w0[l], w_up[l], a0[l], a_up[l], g_up[l], k_k[l], k_a[l],
                                 r_k[l], gn_w[l], gn_b[l])
        q = _dwconv3(p[..., RWKV_COLS:], hy_conv_w[l], hy_conv_b[l])
        y_hy = _hyena_mix(q, flt_w1[l], flt_b1[l], flt_w_in[l], flt_b_in[l], flt_freq[l],
                          flt_w_out[l], hy_bias[l])
        mix = jnp.concatenate([y_rwkv, y_hy], -1) @ w_out[l]
        x = _ln(ALPHA * x + (1 + gt_m) * mix, ln_mix_g[l], ln_mix_b[l])
        h = _ln(x) * (1 + sc_f) + sh_f
        ff = _conv_ffn(h, ffn_up[l], ffn_conv_w[l], ffn_conv_b[l], ffn_down[l])
        x = _ln(ALPHA * x + (1 + gt_f) * ff, ln_ffn_g[l], ln_ffn_b[l])
    return x
```

```cpp
#include <hip/hip_runtime.h>
#include <hip/hip_cooperative_groups.h>
#include <cstdio>
#include <cstdint>
namespace cg = cooperative_groups;
namespace pg8 {
#define PG8_LAS __attribute__((address_space(3)))
typedef unsigned short bf16_t;
typedef short bf16x8 __attribute__((ext_vector_type(8)));
typedef float f32x4 __attribute__((ext_vector_type(4)));
typedef unsigned u32x4 __attribute__((ext_vector_type(4)));
constexpr int BM = 256, BK = 64, HALF = 128, HTB = HALF * BK * 2  , STAGE_BYTES = 8 * HTB, NXCD = 8, WGM = 8;

__host__ __device__ __forceinline__ int lds_byte(int r, int c) { const int st = (r >> 4) * 2 + (c >> 5), rr = r & 15, cc = c & 31, ob = rr * 64 + cc * 2; return st * 1024 + (ob ^ (((ob >> 9) & 1) << 5)); }
__host__ __device__ __forceinline__ void stage_rc(int b, int& R, int& C) { const int st = b / 1024, sb = b % 1024, swz = sb ^ (((sb >> 9) & 1) << 5); R = (st >> 1) * 16 + swz / 64; C = (st & 1) * 32 + (swz % 64) / 2; }
__host__ __device__ __forceinline__ int perm32(int rho) { const int n = rho >> 4, i = rho & 15; return 8 * (i >> 2) + 4 * n + (i & 3); }

struct Unit { int pm, pn; };
struct Gemm { const bf16_t* A; const bf16_t* Bt; int M, N, K; };

struct StaticOrder {
    int nM, nN, nwg, G, c;
    __host__ __device__ void init(int M, int N, int G_, int c_) { nM = M / BM; nN = N / BM; nwg = nM * nN; G = G_; c = c_; }
    __host__ __device__ bool next(int i, Unit& u) const {
        const long L = (long)i * G + c; if (L >= nwg) return false;
        int wgid = (int)L; { const int q = nwg / NXCD, r = nwg % NXCD, xcd = wgid % NXCD, off = wgid / NXCD; wgid = (xcd < r ? xcd * (q + 1) : r * (q + 1) + (xcd - r) * q) + off; }
        const int nig = WGM * nN, gid = wgid / nig, fm = gid * WGM, gsz = (nM - fm) < WGM ? (nM - fm) : WGM;
        u.pm = fm + ((wgid % nig) % gsz); u.pn = (wgid % nig) / gsz; return true;
    }
    __device__ __forceinline__ void a_ready(const Unit&) const {}
    __device__ __forceinline__ void done(const Unit&) const {}
};
__device__ __forceinline__ unsigned cvt_pk_bf16(float lo, float hi) { unsigned r; asm volatile("v_cvt_pk_bf16_f32 %0, %1, %2" : "=v"(r) : "v"(lo), "v"(hi)); return r; }
typedef float f32x2 __attribute__((ext_vector_type(2)));
__device__ __forceinline__ f32x2 gelu_pk(f32x2 v) {
    const f32x2 av = __builtin_elementwise_abs(v), d = av * 0.2316418882f + 1.0f;
    f32x2 t; t.x = __builtin_amdgcn_rcpf(d.x); t.y = __builtin_amdgcn_rcpf(d.y);
    f32x2 q = t * 0.5307027145f + (-0.7265760135f); q = q * t + 0.7107068705f; q = q * t + (-0.142248368f); q = q * t + 0.127414796f; q = q * t;
    const f32x2 s = (v * v) * (-0.72134752044f);
    f32x2 e; e.x = __builtin_amdgcn_exp2f(s.x); e.y = __builtin_amdgcn_exp2f(s.y);
    const f32x2 m = v * (q * e), r = v - m;
    f32x2 o; o.x = v.x < 0.f ? m.x : r.x; o.y = v.y < 0.f ? m.y : r.y; return o;
}
template <class Epi, class Sched, bool STAMP = false>
__device__ __forceinline__ void gemm_phase(PG8_LAS unsigned char* lds, const Gemm g, const Sched& S, const Epi& E, unsigned long long* stamps) {
    int tid = threadIdx.x; asm volatile("" : "+v"(tid)); const int wid = __builtin_amdgcn_readfirstlane(tid >> 6), lane = tid & 63, wr = wid >> 2, wc = wid & 3, fr = lane & 15, fq = lane >> 4;
    const int K = g.K, nt = K / BK;
    int ts_lo = 0, ts_hi = 0, nts = 0; const unsigned long long rt_entry = STAMP ? (unsigned long long)wall_clock64() : 0ull;
#define PG8_STAMP() do { if (STAMP && wid == 0 && nts < 64) { const unsigned long long _c = (unsigned long long)clock64(); \
        ts_lo = (lane == nts) ? (int)(unsigned)_c : ts_lo; ts_hi = (lane == nts) ? (int)(unsigned)(_c >> 32) : ts_hi; ++nts; } } while (0)
    PG8_STAMP();
    unsigned voffA[2], voffB[2];
#pragma unroll
    for (int i = 0; i < 2; ++i) { int R, C; stage_rc(tid * 16 + i * 8192, R, C); const int Rb = Epi::PERM ? ((R & ~31) + perm32(R & 31)) : R;
        voffA[i] = (unsigned)(R * K + C) * 2u; voffB[i] = (unsigned)(Rb * K + C) * 2u; }
    const size_t kstep = (size_t)(BK * 2);
    const size_t hstep = (size_t)HALF * K * 2;
    const size_t tstep = 2 * hstep;
    const unsigned ldsw = (unsigned)wid * 1024u;
    const int aoff = lds_byte(wr * 64 + fr, fq * 8), boff = lds_byte(wc * 32 + fr, fq * 8);
#define PG8_SA(b, h) (((b) * 2 + (h)) * HTB)
#define PG8_SB(b, h) ((4 + (b) * 2 + (h)) * HTB)
#define PG8_STAGE(bufoff, gbase, voff) do { _Pragma("unroll") for (int _i = 0; _i < 2; ++_i) \
        __builtin_amdgcn_global_load_lds((const unsigned*)((const char*)(gbase) + (voff)[_i]), (PG8_LAS unsigned*)(lds + (bufoff) + ldsw + _i * 8192), 16, 0, 0); } while (0)
#define PG8_LDA(dst, b, h) do { _Pragma("unroll") for (int m = 0; m < 4; ++m) _Pragma("unroll") for (int k = 0; k < 2; ++k) dst[m][k] = *(const PG8_LAS bf16x8*)(lds + PG8_SA(b, h) + aoff + m * 2048 + k * 1024); } while (0)
#define PG8_LDB(dst, b, h) do { _Pragma("unroll") for (int n = 0; n < 2; ++n) _Pragma("unroll") for (int k = 0; k < 2; ++k) dst[n][k] = *(const PG8_LAS bf16x8*)(lds + PG8_SB(b, h) + boff + n * 2048 + k * 1024); } while (0)
#define PG8_MMA(ai, bj, At, Bt) do { __builtin_amdgcn_s_setprio(1); _Pragma("unroll") for (int m = 0; m < 4; ++m) _Pragma("unroll") for (int n = 0; n < 2; ++n) _Pragma("unroll") for (int k = 0; k < 2; ++k) \
        acc[ai][bj][m][n] = __builtin_amdgcn_mfma_f32_16x16x32_bf16(Bt[n][k], At[m][k], acc[ai][bj][m][n], 0, 0, 0); __builtin_amdgcn_s_setprio(0); } while (0)
#define PG8_WAIT_V(n) asm volatile("s_waitcnt vmcnt(" #n ")" ::: "memory")
#define PG8_WAIT_L(n) asm volatile("s_waitcnt lgkmcnt(" #n ")" ::: "memory")
#define PG8_BAR __builtin_amdgcn_s_barrier()
#define PG8_SCHED __builtin_amdgcn_sched_barrier(0)
    Unit cur, nxt; int ui = 0;
    if (!S.next(0, cur)) return;
    f32x4 acc[2][2][4][2];
#pragma unroll
    for (int a = 0; a < 2; ++a)
#pragma unroll
        for (int b = 0; b < 2; ++b)
#pragma unroll
            for (int m = 0; m < 4; ++m)
#pragma unroll
                for (int n = 0; n < 2; ++n) acc[a][b][m][n] = (f32x4){0.f, 0.f, 0.f, 0.f};
    bf16x8 At[4][2], B0[2][2], B1[2][2];
    const char* cA = (const char*)g.A + (size_t)cur.pm * tstep; const char* cB = (const char*)g.Bt + (size_t)cur.pn * tstep;
    S.a_ready(cur);
    PG8_STAGE(PG8_SB(0, 0), cB, voffB); PG8_STAGE(PG8_SA(0, 0), cA, voffA); PG8_STAGE(PG8_SB(0, 1), cB + hstep, voffB); PG8_STAGE(PG8_SA(0, 1), cA + hstep, voffA);
    if (wr == 1) PG8_BAR;
    PG8_WAIT_V(4); PG8_BAR;
    PG8_STAGE(PG8_SB(1, 0), cB + kstep, voffB); PG8_STAGE(PG8_SA(1, 0), cA + kstep, voffA); PG8_STAGE(PG8_SB(1, 1), cB + hstep + kstep, voffB);
    PG8_WAIT_V(6); PG8_BAR;
    PG8_STAMP();
    for (;;) {
        const bool has_next = S.next(ui + 1, nxt);
        const char* nA = has_next ? (const char*)g.A + (size_t)nxt.pm * tstep : cA; const char* nB = has_next ? (const char*)g.Bt + (size_t)nxt.pn * tstep : cB;
        for (int t = 0; t < nt; t += 2) {
            const bool last = (t == nt - 2);
            const char* a1 = cA + (size_t)(t + 1) * kstep;
            const char* a2 = last ? nA : cA + (size_t)(t + 2) * kstep; const char* b2 = last ? nB : cB + (size_t)(t + 2) * kstep;
            const char* a3 = a2 + kstep; const char* b3 = b2 + kstep;
            if (last && has_next) S.a_ready(nxt);
            PG8_LDB(B0, 0, 0); PG8_SCHED; PG8_LDA(At, 0, 0); PG8_STAGE(PG8_SA(1, 1), a1 + hstep, voffA);
            PG8_WAIT_L(8); PG8_BAR; PG8_WAIT_L(0); PG8_MMA(0, 0, At, B0); PG8_BAR; PG8_SCHED;
            PG8_LDB(B1, 0, 1); PG8_STAGE(PG8_SB(0, 0), b2, voffB);
            PG8_BAR; PG8_WAIT_L(0); PG8_MMA(0, 1, At, B1); PG8_BAR;
            PG8_LDA(At, 0, 1); PG8_STAGE(PG8_SA(0, 0), a2, voffA);
            PG8_BAR; PG8_WAIT_L(0); PG8_MMA(1, 0, At, B0); PG8_BAR; PG8_SCHED;
            PG8_STAGE(PG8_SB(0, 1), b2 + hstep, voffB);
            PG8_WAIT_V(6); PG8_BAR; PG8_MMA(1, 1, At, B1); PG8_BAR;
            PG8_LDB(B0, 1, 0); PG8_SCHED; PG8_LDA(At, 1, 0); PG8_STAGE(PG8_SA(0, 1), a2 + hstep, voffA);
            PG8_WAIT_L(8); PG8_BAR; PG8_WAIT_L(0); PG8_MMA(0, 0, At, B0); PG8_BAR; PG8_SCHED;
            PG8_LDB(B1, 1, 1); PG8_STAGE(PG8_SB(1, 0), b3, voffB);
            PG8_BAR; PG8_WAIT_L(0); PG8_MMA(0, 1, At, B1); PG8_BAR;
            PG8_LDA(At, 1, 1); PG8_STAGE(PG8_SA(1, 0), a3, voffA);
            PG8_BAR; PG8_WAIT_L(0); PG8_MMA(1, 0, At, B0); PG8_BAR; PG8_SCHED;
            PG8_STAGE(PG8_SB(1, 1), b3 + hstep, voffB);
            PG8_WAIT_V(6); PG8_BAR; PG8_MMA(1, 1, At, B1); PG8_BAR;
        }
        PG8_STAMP();
        if constexpr (!Epi::AFTER_DRAIN) { E(acc, cur, wr, wc, fr, fq); S.done(cur); }
        PG8_STAMP();
        if (!has_next) break;
#pragma unroll
        for (int a = 0; a < 2; ++a)
#pragma unroll
            for (int b = 0; b < 2; ++b)
#pragma unroll
                for (int m = 0; m < 4; ++m)
#pragma unroll
                    for (int n = 0; n < 2; ++n) acc[a][b][m][n] = (f32x4){0.f, 0.f, 0.f, 0.f};
        cur = nxt; cA = nA; cB = nB; ++ui;
    }
    PG8_WAIT_V(0);
    if (wr == 0) PG8_BAR;
    PG8_BAR;
    if constexpr (Epi::AFTER_DRAIN) { E.fused(acc, cur, wr, wc, fr, fq, lds, wid, lane); S.done(cur); }
    PG8_STAMP();
    if (STAMP && wid == 0) { stamps[lane] = lane < nts ? (((unsigned long long)(unsigned)ts_hi << 32) | (unsigned)ts_lo) : 0ull;
        if (lane == 62) stamps[62] = rt_entry; if (lane == 63) stamps[63] = (unsigned long long)wall_clock64(); }
#undef PG8_STAMP
#undef PG8_SA
#undef PG8_SB
#undef PG8_STAGE
#undef PG8_LDA
#undef PG8_LDB
#undef PG8_MMA
#undef PG8_WAIT_V
#undef PG8_WAIT_L
#undef PG8_BAR
#undef PG8_SCHED
}
}

using pg8::bf16_t; using pg8::bf16x8; using pg8::f32x4; using pg8::u32x4; using pg8::Unit; using pg8::f32x2;
typedef unsigned short u16;
typedef float f32x16 __attribute__((ext_vector_type(16)));
typedef bf16x8 bf16x8_a4 __attribute__((aligned(4)));
typedef u32x4 u32x4_a4 __attribute__((aligned(4)));
typedef unsigned u32x2 __attribute__((ext_vector_type(2)));
#define DEVI __device__ __forceinline__
#define LAS __attribute__((address_space(3)))
#define LDS_WAIT() asm volatile("s_waitcnt lgkmcnt(0)" ::: "memory")

constexpr int T_ = 2048, MTOK = 65536;
constexpr float ALPHA_ = 1.41421356237f, LN_EPS_ = 1e-5f, GN_EPS_ = 64e-5f;
constexpr size_t MiB = 1u << 20;
constexpr size_t OFF_WINT = 1 * MiB, OFF_WOT = 15 * MiB, OFF_WUT = 19 * MiB, OFF_WDT = 41 * MiB, OFF_LT = 52 * MiB, OFF_MOD = 53 * MiB, OFF_GT = 55 * MiB,
                 OFF_A = 72 * MiB, OFF_B = 200 * MiB;
constexpr size_t OFF_PR = OFF_B, OFF_PH = OFF_B + 256 * MiB, OFF_UT = OFF_B + 448 * MiB, OFF_X0 = OFF_B + 512 * MiB, OFF_CONVT = OFF_B + 576 * MiB;
constexpr size_t OFF_EF = OFF_B + 256 * MiB, OFF_EB = OFF_B + 320 * MiB, OFF_AF = OFF_B + 384 * MiB, OFF_AB = OFF_B + 448 * MiB, OFF_G = OFF_B + 512 * MiB,
                 OFF_YF = OFF_B + 576 * MiB, OFF_YB = OFF_B + 640 * MiB;
constexpr size_t OFF_UA = OFF_B, OFF_UG = OFF_B + 352 * MiB;
constexpr size_t WS_NEED = OFF_B + 704 * MiB;
constexpr int GT_STRIDE = 4112;
constexpr int LT_PER_LAYER = 2 * 512 * 64 * 2 + 512 * 160;

struct Params { const float* in[36]; float* out; unsigned char* ws; };
enum { I_X = 0, I_C, I_WADA, I_BADA, I_ADAT, I_WIN, I_MUP, I_MUN, I_HCW, I_HCB, I_W0, I_WUP, I_A0, I_AUP, I_GUP, I_KK, I_KA, I_RK, I_GNW, I_GNB,
       I_FW1, I_FB1, I_FWIN, I_FBIN, I_FFREQ, I_FWOUT, I_HBIAS, I_WOUT, I_LMG, I_LMB, I_FUP, I_FCW, I_FCB, I_FDN, I_LFG, I_LFB };

DEVI u16 f2bf(float f) { unsigned u = __float_as_uint(f); u += 0x7FFFu + ((u >> 16) & 1u); return (u16)(u >> 16); }
DEVI float bf2f(unsigned b) { return __uint_as_float(b << 16); }
DEVI float bflo(unsigned w) { return __uint_as_float(w << 16); }
DEVI float bfhi(unsigned w) { return __uint_as_float(w & 0xFFFF0000u); }
DEVI unsigned pk2(float lo, float hi) { return pg8::cvt_pk_bf16(lo, hi); }
DEVI float wave_sum(float v) {
#pragma unroll
    for (int o = 1; o < 64; o <<= 1) v += __shfl_xor(v, o);
    return v;
}
DEVI float sum8(float v) { v += __shfl_xor(v, 1); v += __shfl_xor(v, 2); v += __shfl_xor(v, 4); return v; }
DEVI float sigmoidf_(float x) { return 1.f / (1.f + __expf(-x)); }
DEVI void unpack8(const u32x4 w, float (&o)[8]) { o[0] = bflo(w.x); o[1] = bfhi(w.x); o[2] = bflo(w.y); o[3] = bfhi(w.y); o[4] = bflo(w.z); o[5] = bfhi(w.z); o[6] = bflo(w.w); o[7] = bfhi(w.w); }
DEVI u32x4 pack8(const float (&v)[8]) { u32x4 w; w.x = pk2(v[0], v[1]); w.y = pk2(v[2], v[3]); w.z = pk2(v[4], v[5]); w.w = pk2(v[6], v[7]); return w; }
DEVI void load8f(const float* p, float (&o)[8]) { const f32x4 a = *(const f32x4*)p, b = *(const f32x4*)(p + 4); o[0] = a.x; o[1] = a.y; o[2] = a.z; o[3] = a.w; o[4] = b.x; o[5] = b.y; o[6] = b.z; o[7] = b.w; }

struct EpiSplitBf16 {
    static constexpr bool PERM = true, AFTER_DRAIN = false;
    u16* O0; u16* O1; int nsplit, ld0, ld1;
    __device__ __forceinline__ void operator()(const f32x4 (&acc)[2][2][4][2], const Unit& u, int wr, int wc, int fr, int fq) const {
        const int row0 = u.pm * 256 + wr * 64 + fr;
        u16* base; int ldc, colt;
        if (u.pn < nsplit) { base = O0; ldc = ld0; colt = u.pn * 256; } else { base = O1; ldc = ld1; colt = (u.pn - nsplit) * 256; }
        const int col0 = colt + wc * 32 + 8 * fq;
#pragma unroll
        for (int ai = 0; ai < 2; ++ai)
#pragma unroll
            for (int m = 0; m < 4; ++m) { u16* rowp = base + (size_t)(row0 + ai * 128 + m * 16) * ldc + col0;
#pragma unroll
                for (int bj = 0; bj < 2; ++bj) { const f32x4 v0 = acc[ai][bj][m][0], v1 = acc[ai][bj][m][1];
                    u32x4 w; w.x = pk2(v0[0], v0[1]); w.y = pk2(v0[2], v0[3]); w.z = pk2(v1[0], v1[1]); w.w = pk2(v1[2], v1[3]);
                    *(u32x4*)(rowp + bj * 128) = w; } }
    }
};
struct EpiRes {
    static constexpr bool PERM = false, AFTER_DRAIN = false;
    const float* xin; float* xout; const float* gate;
    __device__ __forceinline__ void operator()(const f32x4 (&acc)[2][2][4][2], const Unit& u, int wr, int wc, int fr, int fq) const {
        const int row0 = u.pm * 256 + wr * 64 + fr, col0 = u.pn * 256 + wc * 32 + 4 * fq;
        const float* gp = gate + (size_t)(u.pm >> 3) * 6144 + col0;
        f32x4 gv[2][2];
#pragma unroll
        for (int bj = 0; bj < 2; ++bj)
#pragma unroll
            for (int n = 0; n < 2; ++n) gv[bj][n] = *(const f32x4*)(gp + bj * 128 + n * 16) + 1.0f;
#pragma unroll
        for (int ai = 0; ai < 2; ++ai)
#pragma unroll
            for (int m = 0; m < 4; ++m) { const size_t off = (size_t)(row0 + ai * 128 + m * 16) * 1024 + col0;
#pragma unroll
                for (int bj = 0; bj < 2; ++bj)
#pragma unroll
                    for (int n = 0; n < 2; ++n) { const f32x4 xv = *(const f32x4*)(xin + off + bj * 128 + n * 16);
                        *(f32x4*)(xout + off + bj * 128 + n * 16) = xv * ALPHA_ + gv[bj][n] * acc[ai][bj][m][n]; } }
    }
};

template <class Epi> DEVI void run_gemm(LAS unsigned char* lds, const u16* A, const u16* Bt, int N, int K, const Epi& E) {
    pg8::Gemm g; g.A = A; g.Bt = Bt; g.M = MTOK; g.N = N; g.K = K;
    pg8::StaticOrder S; S.init(MTOK, N, (int)gridDim.x, (int)blockIdx.x);
    pg8::gemm_phase<Epi, pg8::StaticOrder, false>(lds, g, S, E, nullptr);
}

DEVI void transpose_item(const float* W, int K, int N, u16* WT, int drow, LAS float* scr, int k0, int n0, int lane) {
#pragma unroll 8
    for (int i = 0; i < 32; ++i) { const int kk = 2 * i + (lane >> 5); scr[kk * 33 + (lane & 31)] = W[(size_t)(k0 + kk) * N + n0 + (lane & 31)]; }
    LDS_WAIT();
    const int c = lane & 7;
#pragma unroll
    for (int j = 0; j < 4; ++j) { const int n = (lane >> 3) + 8 * j; const LAS float* s = scr + (8 * c) * 33 + n;
        u32x4 o; o.x = pk2(s[0 * 33], s[1 * 33]); o.y = pk2(s[2 * 33], s[3 * 33]); o.z = pk2(s[4 * 33], s[5 * 33]); o.w = pk2(s[6 * 33], s[7 * 33]);
        *(u32x4*)(WT + (size_t)(drow + n) * K + k0 + 8 * c) = o; }
    LDS_WAIT();
}

DEVI void phase_prologue(const Params& P, LAS unsigned char* lds) {
    int tid_l = threadIdx.x; asm volatile("" : "+v"(tid_l));
    const int tid = tid_l, lane = tid & 63, wave = tid >> 6;
    unsigned char* ws = P.ws; asm volatile("" : "+s"(ws));
    float* MOD = (float*)(ws + OFF_MOD);
    {
        LAS float* red = (LAS float*)lds;
        const float* cin = P.in[I_C]; const float* W = P.in[I_WADA];
        const int r = lane & 31, hh = lane >> 5;
        for (int item = blockIdx.x; item < 192; item += gridDim.x) {
            const int n0 = item * 32;
            f32x16 acc;
#pragma unroll
            for (int i = 0; i < 16; ++i) acc[i] = 0.f;
#pragma unroll 4
            for (int ks = 0; ks < 64; ++ks) {
                const int k = wave * 128 + ks * 2 + hh;
                const float cv = cin[r * 1024 + k]; const float a = cv / (1.f + expf(-cv));
                const float bv = W[(size_t)k * 6144 + n0 + r];
                acc = __builtin_amdgcn_mfma_f32_32x32x2f32(a, bv, acc, 0, 0, 0);
            }
#pragma unroll
            for (int rg = 0; rg < 16; ++rg) { const int row = (rg & 3) + 8 * (rg >> 2) + 4 * hh; red[(wave * 32 + row) * 32 + r] = acc[rg]; }
            __syncthreads();
            for (int e = tid; e < 1024; e += 512) {
                const int row = e >> 5, col = e & 31; float s = 0.f;
#pragma unroll
                for (int w = 0; w < 8; ++w) s += red[(w * 32 + row) * 32 + col];
                const int n = n0 + col; s += P.in[I_BADA][n];
                const int gi = n >> 10, nn = n & 1023;
#pragma unroll
                for (int l = 0; l < 2; ++l) MOD[((size_t)(l * 32 + row) * 6 + gi) * 1024 + nn] = s + P.in[I_ADAT][(l * 6 + gi) * 1024 + nn];
            }
            __syncthreads();
        }
    }
    {
        LAS float* scr = (LAS float*)(lds + 32768) + wave * (64 * 33);
        const int gw = blockIdx.x * 8 + wave, NGW = gridDim.x * 8;
        u16* WINT = (u16*)(ws + OFF_WINT); u16* WOT = (u16*)(ws + OFF_WOT); u16* WUT = (u16*)(ws + OFF_WUT); u16* WDT = (u16*)(ws + OFF_WDT);
        for (int it = gw; it < 2 * 6480; it += NGW) {
            const int l = it / 6480; int r = it % 6480;
            if (r < 1744) { const int kb = r / 109, nb = r % 109, n0 = nb * 32, drow = n0 < 1952 ? n0 : n0 + 96;
                transpose_item(P.in[I_WIN] + (size_t)l * 1024 * 3488, 1024, 3488, WINT + (size_t)l * 3584 * 1024, drow, scr, kb * 64, n0, lane); continue; }
            r -= 1744;
            if (r < 512) { const int kb = r / 32, nb = r % 32;
                transpose_item(P.in[I_WOUT] + (size_t)l * 1024 * 1024, 1024, 1024, WOT + (size_t)l * 1024 * 1024, nb * 32, scr, kb * 64, nb * 32, lane); continue; }
            r -= 512;
            if (r < 2816) { const int kb = r / 176, nb = r % 176;
                transpose_item(P.in[I_FUP] + (size_t)l * 1024 * 5632, 1024, 5632, WUT + (size_t)l * 5632 * 1024, nb * 32, scr, kb * 64, nb * 32, lane); continue; }
            r -= 2816;
            { const int kb = r / 32, nb = r % 32;
                transpose_item(P.in[I_FDN] + (size_t)l * 2816 * 1024, 2816, 1024, WDT + (size_t)l * 1024 * 2816, nb * 32, scr, kb * 64, nb * 32, lane); }
        }
        const int gtid = blockIdx.x * 512 + tid, NT = gridDim.x * 512;
        for (int i = gtid; i < 2 * 96 * 128; i += NT) { const int l = i / (96 * 128), rr = i % (96 * 128);
            *(u32x4*)(WINT + (size_t)l * 3584 * 1024 + (size_t)1952 * 1024 + (size_t)rr * 8) = (u32x4){0u, 0u, 0u, 0u}; }
        u16* LT = (u16*)(ws + OFF_LT);
        for (int i = gtid; i < 2 * LT_PER_LAYER; i += NT) {
            const int l = i / LT_PER_LAYER; int e = i % LT_PER_LAYER; float v;
            if (e < 65536) { const int d = e >> 15, n = (e >> 6) & 511, k = e & 63; v = P.in[I_WUP][((size_t)(l * 2 + d) * 64 + k) * 512 + n]; }
            else if (e < 131072) { const int e2 = e - 65536; const int d = e2 >> 15, n = (e2 >> 6) & 511, k = e2 & 63; v = P.in[I_AUP][((size_t)(l * 2 + d) * 64 + k) * 512 + n]; }
            else { const int e2 = e - 131072; const int n = e2 / 160, k = e2 % 160; v = P.in[I_GUP][((size_t)l * 160 + k) * 512 + n]; }
            LT[i] = f2bf(v);
        }
    }
    __syncthreads();
    {
        LAS float* zb = (LAS float*)lds;
        LAS float* hb0 = zb + 8 * 36;
        LAS float* hb1 = hb0 + 64 * 8;
        u16* GT = (u16*)(ws + OFF_GT);
        const int p = tid >> 6, j = tid & 63;
        for (int item = blockIdx.x; item < 512; item += gridDim.x) {
            const int l = item >> 8, i0 = (item & 255) * 8, i = i0 + p;
            const float t = (float)i * (1.0f / 2047.0f);
            if (j < 33) {
                float z;
                if (j == 0) z = t;
                else { const int bnd = (j - 1) & 15; const float f = 1e-4f + (float)bnd * ((15.0f - 1e-4f) / 15.0f);
                    const float ang = (6.283185307179586f / 2048.0f) * (float)i * f; z = (j <= 16) ? cosf(ang) : -sinf(ang); }
                zb[p * 36 + j] = z;
            }
            __syncthreads();
            const float fr = P.in[I_FFREQ][l * 64 + j];
            { float a = P.in[I_FB1][l * 64 + j]; const float* w1 = P.in[I_FW1] + (size_t)l * 33 * 64 + j;
#pragma unroll 3
                for (int m = 0; m < 33; ++m) a += zb[p * 36 + m] * w1[m * 64];
                hb0[j * 8 + p] = sinf(fr * a); }
            __syncthreads();
            { float a = P.in[I_FBIN][(l * 2 + 0) * 64 + j]; const float* w = P.in[I_FWIN] + (size_t)(l * 2 + 0) * 4096 + j;
#pragma unroll 4
                for (int m = 0; m < 64; ++m) a += hb0[m * 8 + p] * w[m * 64];
                hb1[j * 8 + p] = sinf(fr * a); }
            __syncthreads();
            { float a = P.in[I_FBIN][(l * 2 + 1) * 64 + j]; const float* w = P.in[I_FWIN] + (size_t)(l * 2 + 1) * 4096 + j;
#pragma unroll 4
                for (int m = 0; m < 64; ++m) a += hb1[m * 8 + p] * w[m * 64];
                a = sinf(fr * a);
                __syncthreads();
                hb0[j * 8 + p] = a; }
            __syncthreads();
#pragma unroll
            for (int qq = 0; qq < 2; ++qq) {
                const int n = j + 64 * (p + 8 * qq);
                float acc8[8];
#pragma unroll
                for (int pp = 0; pp < 8; ++pp) acc8[pp] = 0.f;
                const float* wo = P.in[I_FWOUT] + (size_t)l * 64 * 1024 + n;
#pragma unroll 4
                for (int m = 0; m < 64; ++m) { const float w = wo[m * 1024]; const f32x4 h0 = *(const LAS f32x4*)(hb0 + m * 8), h1 = *(const LAS f32x4*)(hb0 + m * 8 + 4);
                    acc8[0] += h0.x * w; acc8[1] += h0.y * w; acc8[2] += h0.z * w; acc8[3] += h0.w * w; acc8[4] += h1.x * w; acc8[5] += h1.y * w; acc8[6] += h1.z * w; acc8[7] += h1.w * w; }
                const int c = n & 511;
                const float dl = fabsf(-3.0701134573f + (float)c * ((-15.3505672866f + 3.0701134573f) / 511.0f));
                u16* g0 = GT + ((size_t)(l * 512 + c) * 2) * GT_STRIDE; u16* g1 = g0 + GT_STRIDE;
#pragma unroll
                for (int pp = 0; pp < 8; ++pp) {
                    const int ii = i0 + pp; const float tt = (float)ii * (1.0f / 2047.0f);
                    float val = acc8[pp] * expf(-tt * dl);
                    int idx;
                    if (n < 512) { idx = 2048 - ii; if (ii == 0) val += P.in[I_HBIAS][l * 512 + c]; } else { idx = 2048 + ii; }
                    if (n < 512 || ii > 0) { const u16 hv = f2bf(val); g0[idx] = hv; g1[idx - 1] = hv; }
                }
            }
            __syncthreads();
        }
    }
}

template <int MODE> DEVI void phase_ln(const float* src, float* dst, const float* g, const float* bta, const float* modsh, const float* modsc, u16* H) {
    int tid_l = threadIdx.x; asm volatile("" : "+v"(tid_l));
    const int lane = tid_l & 63, wave = tid_l >> 6;
    const int gw = blockIdx.x * 8 + wave, NGW = gridDim.x * 8;
    for (int row = gw; row < MTOK; row += NGW) {
        const f32x4* xr = (const f32x4*)(src + (size_t)row * 1024) + lane;
        f32x4 v[4]; float s = 0.f;
#pragma unroll
        for (int j = 0; j < 4; ++j) { v[j] = xr[64 * j]; s += (v[j].x + v[j].y) + (v[j].z + v[j].w); }
        float mean = wave_sum(s) * (1.f / 1024.f); float s2 = 0.f;
#pragma unroll
        for (int j = 0; j < 4; ++j) { v[j] = v[j] - mean; s2 += (v[j].x * v[j].x + v[j].y * v[j].y) + (v[j].z * v[j].z + v[j].w * v[j].w); }
        float rstd = 1.f / sqrtf(wave_sum(s2) * (1.f / 1024.f) + LN_EPS_);
        if (MODE >= 1) {
            s = 0.f;
#pragma unroll
            for (int j = 0; j < 4; ++j) { const f32x4 gg = *((const f32x4*)g + lane + 64 * j), bb = *((const f32x4*)bta + lane + 64 * j);
                v[j] = v[j] * rstd * gg + bb; *((f32x4*)(dst + (size_t)row * 1024) + lane + 64 * j) = v[j]; s += (v[j].x + v[j].y) + (v[j].z + v[j].w); }
            if (MODE == 1) {
                mean = wave_sum(s) * (1.f / 1024.f); s2 = 0.f;
#pragma unroll
                for (int j = 0; j < 4; ++j) { v[j] = v[j] - mean; s2 += (v[j].x * v[j].x + v[j].y * v[j].y) + (v[j].z * v[j].z + v[j].w * v[j].w); }
                rstd = 1.f / sqrtf(wave_sum(s2) * (1.f / 1024.f) + LN_EPS_);
            }
        }
        if (MODE <= 1) {
            const int b = row >> 11;
            const f32x4* sh = (const f32x4*)(modsh + (size_t)b * 6144) + lane; const f32x4* sc = (const f32x4*)(modsc + (size_t)b * 6144) + lane;
            unsigned long long* o8 = (unsigned long long*)(H + (size_t)row * 1024) + lane;
#pragma unroll
            for (int j = 0; j < 4; ++j) { const f32x4 y = v[j] * rstd * (sc[64 * j] + 1.0f) + sh[64 * j];
                o8[64 * j] = (unsigned long long)pk2(y.x, y.y) | ((unsigned long long)pk2(y.z, y.w) << 32); }
        }
    }
}

DEVI void phase_hy_prep(const Params& P, int l, LAS unsigned char* lds) {
    int tid_l = threadIdx.x; asm volatile("" : "+v"(tid_l));
    unsigned char* ws = P.ws; asm volatile("" : "+s"(ws)); asm volatile("" : "+s"(l));
    const int tid = tid_l;
    LAS u16* tile = (LAS u16*)lds;
    const u16* PH = (const u16*)(ws + OFF_PH); u16* UT = (u16*)(ws + OFF_UT); u16* X0 = (u16*)(ws + OFF_X0);
    const int c = tid;
    float w[3][3], bs[3];
#pragma unroll
    for (int i = 0; i < 3; ++i) { const int col = i * 512 + c;
#pragma unroll
        for (int tp = 0; tp < 3; ++tp) w[i][tp] = P.in[I_HCW][((size_t)l * 3 + tp) * 1536 + col];
        bs[i] = P.in[I_HCB][(size_t)l * 1536 + col]; }
    for (int item = blockIdx.x; item < 1024; item += gridDim.x) {
        const int b = item >> 5, t0 = (item & 31) * 64;
        const u16* base = PH + ((size_t)b * T_ + t0) * 1536 + c;
        float prev[3], cur[3], nxt[3];
#pragma unroll
        for (int i = 0; i < 3; ++i) { prev[i] = t0 > 0 ? bf2f(base[-1536 + i * 512]) : 0.f; cur[i] = bf2f(base[i * 512]); }
#pragma unroll 8
        for (int tt = 0; tt < 64; ++tt) {
            const bool hasn = (t0 + tt + 1) < T_;
            float q[3];
#pragma unroll
            for (int i = 0; i < 3; ++i) { nxt[i] = hasn ? bf2f(base[(size_t)(tt + 1) * 1536 + i * 512]) : 0.f;
                q[i] = w[i][0] * prev[i] + w[i][1] * cur[i] + w[i][2] * nxt[i] + bs[i]; prev[i] = cur[i]; cur[i] = nxt[i]; }
            X0[((size_t)b * T_ + t0 + tt) * 512 + c] = f2bf(q[0]);
            tile[c * 66 + tt] = f2bf(q[1] * q[2]);
        }
        __syncthreads();
#pragma unroll
        for (int i = 0; i < 8; ++i) { const int cc = (tid >> 3) + 64 * i, seg = tid & 7;
            const LAS unsigned* s = (const LAS unsigned*)(tile + cc * 66 + seg * 8);
            u32x4 o; o.x = s[0]; o.y = s[1]; o.z = s[2]; o.w = s[3];
            *(u32x4*)(UT + ((size_t)cc * 32 + b) * T_ + t0 + seg * 8) = o; }
        __syncthreads();
    }
}

DEVI void phase_hy_conv(const Params& P, int l) {
    int tid_l = threadIdx.x; asm volatile("" : "+v"(tid_l));
    unsigned char* ws = P.ws; asm volatile("" : "+s"(ws)); asm volatile("" : "+s"(l));
    const int lane = tid_l & 63, wave = tid_l >> 6, r = lane & 31, hh = lane >> 5;
    const u16* GT = (const u16*)(ws + OFF_GT); const u16* UT = (const u16*)(ws + OFF_UT); u16* CONVT = (u16*)(ws + OFF_CONVT);
    for (int c = blockIdx.x; c < 512; c += gridDim.x) {
        const u16* gt = GT + ((size_t)(l * 512 + c) * 2) * GT_STRIDE;
        const u16* ut = UT + ((size_t)c * 32 + r) * T_ + 8 * hh;
        f32x16 acc[8];
#pragma unroll
        for (int m = 0; m < 8; ++m)
#pragma unroll
            for (int i = 0; i < 16; ++i) acc[m][i] = 0.f;
        bf16x8 W[16];
        const int lanebase = 2048 + 8 * hh - r - 256 * wave;
#define HY_LOADF(e_) ({ const int st_ = lanebase + 16 * (e_); const int par_ = st_ & 1; *(const bf16x8_a4*)(gt + par_ * GT_STRIDE + (st_ - par_)); })
#pragma unroll
        for (int u = 0; u < 16; ++u) W[u] = (bf16x8){0, 0, 0, 0, 0, 0, 0, 0};
#pragma unroll
        for (int u = 2; u < 16; ++u) W[u] = HY_LOADF(u - 16);
        for (int jj = 0; jj < 8; ++jj) {
#pragma unroll
            for (int u = 0; u < 16; ++u) {
                const int j = jj * 16 + u;
                W[u] = HY_LOADF(j);
                const bf16x8 bfr = *(const bf16x8*)(ut + j * 16);
#pragma unroll
                for (int m = 0; m < 8; ++m) acc[m] = __builtin_amdgcn_mfma_f32_32x32x16_bf16(W[(u - 2 * m) & 15], bfr, acc[m], 0, 0, 0);
            }
        }
#undef HY_LOADF
#pragma unroll
        for (int m = 0; m < 8; ++m) { const int t0 = 32 * (8 * wave + m);
#pragma unroll
            for (int q = 0; q < 4; ++q) { u32x2 o; o.x = pk2(acc[m][4 * q], acc[m][4 * q + 1]); o.y = pk2(acc[m][4 * q + 2], acc[m][4 * q + 3]);
                *(u32x2*)(CONVT + ((size_t)c * 32 + r) * T_ + t0 + 8 * q + 4 * hh) = o; } }
    }
}

DEVI void phase_hy_post(const Params& P, LAS unsigned char* lds) {
    int tid_l = threadIdx.x; asm volatile("" : "+v"(tid_l));
    unsigned char* ws = P.ws; asm volatile("" : "+s"(ws));
    const int tid = tid_l;
    LAS u16* tile = (LAS u16*)lds;
    const u16* CONVT = (const u16*)(ws + OFF_CONVT); const u16* X0 = (const u16*)(ws + OFF_X0); u16* YM = (u16*)(ws + OFF_A);
    for (int item = blockIdx.x; item < 1024; item += gridDim.x) {
        const int b = item >> 5, t0 = (item & 31) * 64;
#pragma unroll
        for (int i = 0; i < 8; ++i) { const int cc = (tid >> 3) + 64 * i, seg = tid & 7;
            const u32x4 o = *(const u32x4*)(CONVT + ((size_t)cc * 32 + b) * T_ + t0 + seg * 8);
            LAS unsigned* s = (LAS unsigned*)(tile + cc * 66 + seg * 8); s[0] = o.x; s[1] = o.y; s[2] = o.z; s[3] = o.w; }
        __syncthreads();
        const int c = tid;
#pragma unroll 8
        for (int tt = 0; tt < 64; ++tt) { const size_t tok = (size_t)b * T_ + t0 + tt;
            YM[tok * 1024 + 512 + c] = f2bf(bf2f(X0[tok * 512 + c]) * bf2f(tile[c * 66 + tt])); }
        __syncthreads();
    }
}

DEVI void phase_rwkv_prep(const Params& P, int l) {
    int tid_l = threadIdx.x; asm volatile("" : "+v"(tid_l));
    unsigned char* ws = P.ws; asm volatile("" : "+s"(ws)); asm volatile("" : "+s"(l));
    const int lane = tid_l & 63, wave = tid_l >> 6, r = lane & 31, hh = lane >> 5;
    const int gw = blockIdx.x * 8 + wave, NGW = gridDim.x * 8;
    const u16* PR = (const u16*)(ws + OFF_PR);
    const u16* LT = (const u16*)(ws + OFF_LT) + (size_t)l * LT_PER_LAYER;
    const float* mup = P.in[I_MUP] + l * 1952; const float* mun = P.in[I_MUN] + l * 1952;
    for (int it = gw; it < 2048 * 5; it += NGW) {
        const int mat = it % 5, tok0 = (it / 5) * 32, tok = tok0 + r, t = tok & 2047;
        const int K = (mat == 4) ? 160 : 64, cbase = (mat == 4) ? 1792 : 1536 + 64 * mat;
        const u16* pr = PR + (size_t)tok * 2048 + cbase + 8 * hh;
        bf16x8 af[10];
#pragma unroll
        for (int kk = 0; kk < 10; ++kk) {
            af[kk] = (bf16x8){0, 0, 0, 0, 0, 0, 0, 0};
            if (kk * 16 < K) {
                float pc[8], pp[8], pn[8], mp[8], mn[8], x[8];
                unpack8(*(const u32x4*)(pr + kk * 16), pc);
                if (t > 0) unpack8(*(const u32x4*)(pr + kk * 16 - 2048), pp); else {
#pragma unroll
                    for (int q = 0; q < 8; ++q) pp[q] = 0.f; }
                if (t < T_ - 1) unpack8(*(const u32x4*)(pr + kk * 16 + 2048), pn); else {
#pragma unroll
                    for (int q = 0; q < 8; ++q) pn[q] = 0.f; }
                load8f(mup + cbase + 8 * hh + kk * 16, mp); load8f(mun + cbase + 8 * hh + kk * 16, mn);
#pragma unroll
                for (int q = 0; q < 8; ++q) { float v = pc[q] + mp[q] * (pp[q] - pc[q]) + mn[q] * (pn[q] - pc[q]);
                    if (mat < 2) v = tanhf(v); else if (mat == 4) v = sigmoidf_(v);
                    x[q] = v; }
                const u32x4 pk = pack8(x);
                af[kk] = __builtin_bit_cast(bf16x8, pk);
            }
        }
        const u16* lt = (mat < 2) ? LT + (size_t)mat * 32768 : (mat < 4) ? LT + 65536 + (size_t)(mat - 2) * 32768 : LT + 131072;
        const float* bias = (mat < 2) ? P.in[I_W0] + (size_t)(l * 2 + mat) * 512 : P.in[I_A0] + (size_t)(l * 2 + (mat & 1)) * 512;
        u16* outp = (u16*)(ws + (mat == 0 ? OFF_EF : mat == 1 ? OFF_EB : mat == 2 ? OFF_AF : mat == 3 ? OFF_AB : OFF_G));
        for (int nt = 0; nt < 16; ++nt) {
            f32x16 acc;
#pragma unroll
            for (int i = 0; i < 16; ++i) acc[i] = 0.f;
            const u16* bp = lt + (size_t)(nt * 32 + r) * K + 8 * hh;
#pragma unroll
            for (int kk = 0; kk < 10; ++kk) if (kk * 16 < K) { const bf16x8 bfr = *(const bf16x8*)(bp + kk * 16); acc = __builtin_amdgcn_mfma_f32_32x32x16_bf16(af[kk], bfr, acc, 0, 0, 0); }
            const float bsv = (mat < 4) ? bias[nt * 32 + r] : 0.f;
#pragma unroll
            for (int rg = 0; rg < 16; ++rg) { const int row = (rg & 3) + 8 * (rg >> 2) + 4 * hh; const float x = acc[rg] + bsv;
                const float val = (mat < 2) ? sigmoidf_(x) * 0.60653065971f : (mat < 4) ? sigmoidf_(x) : x;
                outp[(size_t)(tok0 + row) * 512 + nt * 32 + r] = f2bf(val); }
        }
    }
}

DEVI void phase_scan(const Params& P, int l, LAS unsigned char* lds) {
    int tid_l = threadIdx.x; asm volatile("" : "+v"(tid_l));
    unsigned char* ws = P.ws; asm volatile("" : "+s"(ws)); asm volatile("" : "+s"(l));
    const int lane = tid_l & 63, wave = __builtin_amdgcn_readfirstlane(tid_l >> 6);
    if (wave >= 2) return;
    const int dir = wave;
    LAS float* sm = (LAS float*)lds + wave * 320;
    const u16* PR = (const u16*)(ws + OFF_PR);
    for (int bh = blockIdx.x; bh < 256; bh += gridDim.x) {
        const int b = bh >> 3, h = bh & 7, col = h * 64 + lane;
        const float* mup = P.in[I_MUP] + l * 1952; const float* mun = P.in[I_MUN] + l * 1952;
        const float mAr = dir ? mun[col] : mup[col], mBr = dir ? mup[col] : mun[col];
        const float mAk = dir ? mun[512 + col] : mup[512 + col], mBk = dir ? mup[512 + col] : mun[512 + col];
        const float mAv = dir ? mun[1024 + col] : mup[1024 + col], mBv = dir ? mup[1024 + col] : mun[1024 + col];
        const float kkw = P.in[I_KK][l * 512 + col], kaw = P.in[I_KA][l * 512 + col];
        const u16* prow = PR + (size_t)b * T_ * 2048 + h * 64;
        const u16* Ep = (const u16*)(ws + (dir ? OFF_EB : OFF_EF)) + (size_t)b * T_ * 512 + h * 64;
        const u16* Ap = (const u16*)(ws + (dir ? OFF_AB : OFF_AF)) + (size_t)b * T_ * 512 + h * 64;
        u16* Yp = (u16*)(ws + (dir ? OFF_YB : OFF_YF)) + (size_t)b * T_ * 512 + h * 64;
        f32x2 S[32];
#pragma unroll
        for (int i = 0; i < 32; ++i) S[i] = (f32x2){0.f, 0.f};
        constexpr int CH = 4, NCH = 2048 / CH;
        float cr[CH + 2], ck[CH + 2], cv[CH + 2], ce[CH], ca[CH], nr[CH], nk[CH], nv[CH], ne[CH], na[CH];
#define SCAN_LOAD(ch_, R_, K_, V_, E_, A_) do { \
            _Pragma("unroll") for (int q_ = 0; q_ < CH; ++q_) { const int s_ = (ch_) * CH + 1 + q_; const bool ok_ = s_ < 2048; \
                int tm_ = dir ? 2047 - s_ : s_; tm_ = ok_ ? tm_ : 0; const u16* p_ = prow + (size_t)tm_ * 2048; \
                const float a_ = bf2f(p_[lane]), b_ = bf2f(p_[512 + lane]), c_ = bf2f(p_[1024 + lane]); R_[q_] = ok_ ? a_ : 0.f; K_[q_] = ok_ ? b_ : 0.f; V_[q_] = ok_ ? c_ : 0.f; } \
            _Pragma("unroll") for (int i_ = 0; i_ < CH; ++i_) { const int s_ = (ch_) * CH + i_; const int tm_ = dir ? 2047 - s_ : s_; \
                E_[i_] = bf2f(Ep[(size_t)tm_ * 512 + lane]); A_[i_] = bf2f(Ap[(size_t)tm_ * 512 + lane]); } } while (0)
        { const int tm0 = dir ? 2047 : 0; const u16* p0 = prow + (size_t)tm0 * 2048;
          cr[0] = 0.f; ck[0] = 0.f; cv[0] = 0.f; cr[1] = bf2f(p0[lane]); ck[1] = bf2f(p0[512 + lane]); cv[1] = bf2f(p0[1024 + lane]); }
        SCAN_LOAD(0, nr, nk, nv, ce, ca);
#pragma unroll
        for (int q = 0; q < CH; ++q) { cr[2 + q] = nr[q]; ck[2 + q] = nk[q]; cv[2 + q] = nv[q]; }
#pragma nounroll
        for (int ch = 0; ch < NCH; ++ch) {
            const int chn = ch + 1 < NCH ? ch + 1 : NCH - 1;
            SCAN_LOAD(chn, nr, nk, nv, ne, na);
#pragma unroll
            for (int i = 0; i < CH; ++i) {
                const int s = ch * CH + i, tm = dir ? 2047 - s : s;
                const float r_ = cr[i + 1] + mAr * (cr[i] - cr[i + 1]) + mBr * (cr[i + 2] - cr[i + 1]);
                const float k_ = ck[i + 1] + mAk * (ck[i] - ck[i + 1]) + mBk * (ck[i + 2] - ck[i + 1]);
                const float v_ = cv[i + 1] + mAv * (cv[i] - cv[i + 1]) + mBv * (cv[i + 2] - cv[i + 1]);
                const float kkv = k_ * kkw; const float ss = wave_sum(kkv * kkv);
                const float kkn = kkv / fmaxf(sqrtf(ss), 1e-12f);
                const float a_ = ca[i], w_ = __expf(-ce[i]);
                sm[lane] = -kkn; sm[64 + lane] = w_; sm[128 + lane] = kkn * a_; sm[192 + lane] = k_ * (1.f + (a_ - 1.f) * kaw); sm[256 + lane] = r_;
                f32x2 sza = (f32x2){0.f, 0.f}, szb = (f32x2){0.f, 0.f};
#pragma unroll
                for (int k4 = 0; k4 < 16; ++k4) { const f32x4 z4 = *(const LAS f32x4*)(sm + 4 * k4);
                    sza += S[2 * k4] * (f32x2){z4.x, z4.y}; szb += S[2 * k4 + 1] * (f32x2){z4.z, z4.w}; }
                const float sz = (sza.x + sza.y) + (szb.x + szb.y);
                const f32x2 szv = (f32x2){sz, sz}, vv = (f32x2){v_, v_};
                f32x2 ya = (f32x2){0.f, 0.f}, yb = (f32x2){0.f, 0.f};
#pragma unroll
                for (int k4 = 0; k4 < 16; ++k4) {
                    const f32x4 w4 = *(const LAS f32x4*)(sm + 64 + 4 * k4), b4 = *(const LAS f32x4*)(sm + 128 + 4 * k4), d4 = *(const LAS f32x4*)(sm + 192 + 4 * k4), r4 = *(const LAS f32x4*)(sm + 256 + 4 * k4);
                    S[2 * k4] = S[2 * k4] * (f32x2){w4.x, w4.y} + szv * (f32x2){b4.x, b4.y} + vv * (f32x2){d4.x, d4.y};
                    S[2 * k4 + 1] = S[2 * k4 + 1] * (f32x2){w4.z, w4.w} + szv * (f32x2){b4.z, b4.w} + vv * (f32x2){d4.z, d4.w};
                    ya += S[2 * k4] * (f32x2){r4.x, r4.y}; yb += S[2 * k4 + 1] * (f32x2){r4.z, r4.w};
                }
                Yp[(size_t)tm * 512 + lane] = f2bf((ya.x + ya.y) + (yb.x + yb.y));
            }
            cr[0] = cr[CH]; ck[0] = ck[CH]; cv[0] = cv[CH]; cr[1] = cr[CH + 1]; ck[1] = ck[CH + 1]; cv[1] = cv[CH + 1];
#pragma unroll
            for (int q = 0; q < CH; ++q) { cr[2 + q] = nr[q]; ck[2 + q] = nk[q]; cv[2 + q] = nv[q]; ce[q] = ne[q]; ca[q] = na[q]; }
        }
#undef SCAN_LOAD
    }
}

DEVI void phase_rwkv_post(const Params& P, int l) {
    int tid_l = threadIdx.x; asm volatile("" : "+v"(tid_l));
    unsigned char* ws = P.ws; asm volatile("" : "+s"(ws)); asm volatile("" : "+s"(l));
    const int lane = tid_l & 63, wave = tid_l >> 6;
    const int gw = blockIdx.x * 8 + wave, NGW = gridDim.x * 8;
    const int ch0 = lane * 8;
    const u16* PR = (const u16*)(ws + OFF_PR); const u16* AF = (const u16*)(ws + OFF_AF); const u16* AB = (const u16*)(ws + OFF_AB);
    const u16* G = (const u16*)(ws + OFF_G); const u16* YF = (const u16*)(ws + OFF_YF); const u16* YB = (const u16*)(ws + OFF_YB);
    u16* YM = (u16*)(ws + OFF_A);
    float mp[3][8], mn[3][8], ka[8], gw_[8], gb_[8], rk[8];
#pragma unroll
    for (int i = 0; i < 3; ++i) { load8f(P.in[I_MUP] + l * 1952 + i * 512 + ch0, mp[i]); load8f(P.in[I_MUN] + l * 1952 + i * 512 + ch0, mn[i]); }
    load8f(P.in[I_KA] + l * 512 + ch0, ka); load8f(P.in[I_GNW] + l * 512 + ch0, gw_); load8f(P.in[I_GNB] + l * 512 + ch0, gb_); load8f(P.in[I_RK] + l * 512 + ch0, rk);
    for (int tok = gw; tok < MTOK; tok += NGW) {
        const int t = tok & 2047;
        float x[3][8];
#pragma unroll
        for (int i = 0; i < 3; ++i) {
            const u16* q = PR + (size_t)tok * 2048 + i * 512 + ch0;
            float pc[8], pp[8], pn[8];
            unpack8(*(const u32x4*)q, pc);
            if (t > 0) unpack8(*(const u32x4*)(q - 2048), pp); else {
#pragma unroll
                for (int j = 0; j < 8; ++j) pp[j] = 0.f; }
            if (t < T_ - 1) unpack8(*(const u32x4*)(q + 2048), pn); else {
#pragma unroll
                for (int j = 0; j < 8; ++j) pn[j] = 0.f; }
#pragma unroll
            for (int j = 0; j < 8; ++j) x[i][j] = pc[j] + mp[i][j] * (pp[j] - pc[j]) + mn[i][j] * (pn[j] - pc[j]);
        }
        float af[8], ab[8], g[8], yf[8], yb[8], y[8];
        unpack8(*(const u32x4*)(AF + (size_t)tok * 512 + ch0), af); unpack8(*(const u32x4*)(AB + (size_t)tok * 512 + ch0), ab);
        unpack8(*(const u32x4*)(G + (size_t)tok * 512 + ch0), g);
        unpack8(*(const u32x4*)(YF + (size_t)tok * 512 + ch0), yf); unpack8(*(const u32x4*)(YB + (size_t)tok * 512 + ch0), yb);
        float s = 0.f;
#pragma unroll
        for (int j = 0; j < 8; ++j) { y[j] = yf[j] + yb[j]; s += y[j]; }
        const float mean = sum8(s) * (1.f / 64.f); float s2 = 0.f, bs = 0.f;
#pragma unroll
        for (int j = 0; j < 8; ++j) { y[j] -= mean; s2 += y[j] * y[j];
            const float ks = x[1][j] * (2.f + (af[j] + ab[j] - 2.f) * ka[j]); bs += x[0][j] * ks * rk[j]; }
        const float rstd = 1.f / sqrtf(sum8(s2) * (1.f / 64.f) + GN_EPS_);
        bs = sum8(bs);
        float o[8];
#pragma unroll
        for (int j = 0; j < 8; ++j) o[j] = (y[j] * rstd * gw_[j] + gb_[j] + bs * x[2][j]) * g[j];
        *(u32x4*)(YM + (size_t)tok * 1024 + ch0) = pack8(o);
    }
}

DEVI void phase_act(const Params& P, int l) {
    int tid_l = threadIdx.x; asm volatile("" : "+v"(tid_l));
    unsigned char* ws = P.ws; asm volatile("" : "+s"(ws)); asm volatile("" : "+s"(l));
    const int gtid = blockIdx.x * 512 + tid_l, NT = gridDim.x * 512;
    u16* UA = (u16*)(ws + OFF_UA); const u16* UG = (const u16*)(ws + OFF_UG);
    for (int idx = gtid; idx < 4096 * 352; idx += NT) {
        const int chunk = idx / 352, cg8 = (idx % 352) * 8, tok0 = chunk * 16, t0 = tok0 & 2047;
        float w0[8], w1[8], w2[8], bs[8];
        load8f(P.in[I_FCW] + ((size_t)l * 3 + 0) * 2816 + cg8, w0); load8f(P.in[I_FCW] + ((size_t)l * 3 + 1) * 2816 + cg8, w1);
        load8f(P.in[I_FCW] + ((size_t)l * 3 + 2) * 2816 + cg8, w2); load8f(P.in[I_FCB] + (size_t)l * 2816 + cg8, bs);
        const u16* ug = UG + (size_t)tok0 * 2816 + cg8; u16* ua = UA + (size_t)tok0 * 2816 + cg8;
        float prev[8], cur[8], nxt[8];
        if (t0 > 0) unpack8(*(const u32x4*)(ug - 2816), prev); else {
#pragma unroll
            for (int j = 0; j < 8; ++j) prev[j] = 0.f; }
        unpack8(*(const u32x4*)ug, cur);
#pragma unroll 4
        for (int i = 0; i < 16; ++i) {
            if (t0 + i + 1 < T_) unpack8(*(const u32x4*)(ug + (size_t)(i + 1) * 2816), nxt); else {
#pragma unroll
                for (int j = 0; j < 8; ++j) nxt[j] = 0.f; }
            float a[8], o[8]; unpack8(*(const u32x4*)(ua + (size_t)i * 2816), a);
#pragma unroll
            for (int j = 0; j < 8; j += 2) {
                f32x2 u = (f32x2){w0[j] * prev[j] + w1[j] * cur[j] + w2[j] * nxt[j] + bs[j], w0[j + 1] * prev[j + 1] + w1[j + 1] * cur[j + 1] + w2[j + 1] * nxt[j + 1] + bs[j + 1]};
                const f32x2 gl = pg8::gelu_pk(u); o[j] = gl.x * a[j]; o[j + 1] = gl.y * a[j + 1]; }
            *(u32x4*)(ua + (size_t)i * 2816) = pack8(o);
#pragma unroll
            for (int j = 0; j < 8; ++j) { prev[j] = cur[j]; cur[j] = nxt[j]; }
        }
    }
}

#define LAUNDER_WS() unsigned char* ws = P.ws; asm volatile("" : "+s"(ws)); asm volatile("" : "+s"(l)); float* MOD = (float*)(ws + OFF_MOD); u16* HA = (u16*)(ws + OFF_A); const float* modl = MOD + (size_t)l * 32 * 6144; (void)modl; (void)HA
__global__ void __launch_bounds__(512, 2) mega_fwd(Params P) {
    extern __shared__ __attribute__((aligned(16))) unsigned char smem_[];
    LAS unsigned char* lds = (LAS unsigned char*)smem_;
    cg::grid_group grid = cg::this_grid();
    phase_prologue(P, lds);
    grid.sync();
    { int l = 0; LAUNDER_WS(); phase_ln<0>(P.in[I_X], nullptr, nullptr, nullptr, MOD + 0 * 1024, MOD + 1 * 1024, HA); }
    grid.sync();
#pragma nounroll
    for (int l = 0; l < 2; ++l) {
        { LAUNDER_WS(); EpiSplitBf16 E; E.O0 = (u16*)(ws + OFF_PR); E.O1 = (u16*)(ws + OFF_PH); E.nsplit = 8; E.ld0 = 2048; E.ld1 = 1536;
          run_gemm(lds, HA, (const u16*)(ws + OFF_WINT) + (size_t)l * 3584 * 1024, 3584, 1024, E); }
        grid.sync();
        phase_hy_prep(P, l, lds);
        grid.sync();
        phase_hy_conv(P, l);
        grid.sync();
        phase_hy_post(P, lds);
        grid.sync();
        phase_rwkv_prep(P, l);
        grid.sync();
        phase_scan(P, l, lds);
        grid.sync();
        phase_rwkv_post(P, l);
        grid.sync();
        { LAUNDER_WS(); EpiRes E; E.xin = (l == 0) ? P.in[I_X] : P.out; E.xout = P.out; E.gate = modl + 2 * 1024;
          run_gemm(lds, HA, (const u16*)(ws + OFF_WOT) + (size_t)l * 1024 * 1024, 1024, 1024, E); }
        grid.sync();
        { LAUNDER_WS(); phase_ln<1>(P.out, P.out, P.in[I_LMG] + l * 1024, P.in[I_LMB] + l * 1024, modl + 3 * 1024, modl + 4 * 1024, HA); }
        grid.sync();
        { LAUNDER_WS(); EpiSplitBf16 E; E.O0 = (u16*)(ws + OFF_UA); E.O1 = (u16*)(ws + OFF_UG); E.nsplit = 11; E.ld0 = 2816; E.ld1 = 2816;
          run_gemm(lds, HA, (const u16*)(ws + OFF_WUT) + (size_t)l * 5632 * 1024, 5632, 1024, E); }
        grid.sync();
        phase_act(P, l);
        grid.sync();
        { LAUNDER_WS(); EpiRes E; E.xin = P.out; E.xout = P.out; E.gate = modl + 5 * 1024;
          run_gemm(lds, (const u16*)(ws + OFF_UA), (const u16*)(ws + OFF_WDT) + (size_t)l * 1024 * 2816, 1024, 2816, E); }
        grid.sync();
        { LAUNDER_WS();
          if (l == 0) phase_ln<1>(P.out, P.out, P.in[I_LFG], P.in[I_LFB], MOD + (size_t)32 * 6144 + 0 * 1024, MOD + (size_t)32 * 6144 + 1 * 1024, HA);
          else phase_ln<2>(P.out, P.out, P.in[I_LFG] + 1024, P.in[I_LFB] + 1024, nullptr, nullptr, nullptr); }
        if (l == 0) grid.sync();
    }
}

extern "C" void kernel_launch(void* const* d_in, const int* in_sizes, int n_in, void* d_out, int out_size, void* d_ws, size_t ws_size, hipStream_t stream) {
    static int grid = 0;
    constexpr int LDS_BYTES = 131072;
    if (grid == 0) {
        if (n_in != 36 || out_size != MTOK * 1024 || ws_size < WS_NEED) { fprintf(stderr, "kernel_launch: unexpected shapes (n_in %d out %d ws %zu)\n", n_in, out_size, ws_size); grid = -1; return; }
        int dev = 0, cus = 0, per_cu = 0;
        hipGetDevice(&dev); hipDeviceGetAttribute(&cus, hipDeviceAttributeMultiprocessorCount, dev);
        hipFuncSetAttribute((const void*)mega_fwd, hipFuncAttributeMaxDynamicSharedMemorySize, LDS_BYTES);
        hipOccupancyMaxActiveBlocksPerMultiprocessor(&per_cu, (const void*)mega_fwd, 512, LDS_BYTES);
        if (per_cu < 1) { fprintf(stderr, "kernel_launch: occupancy query says %d blocks/CU\n", per_cu); per_cu = 1; }
        grid = cus;
        (void)hipGetLastError();
    }
    if (grid < 0) return;
    Params p{};
    for (int i = 0; i < 36; ++i) p.in[i] = (const float*)d_in[i];
    p.out = (float*)d_out; p.ws = (unsigned char*)d_ws;
    void* args[] = {&p};
    hipError_t e = hipLaunchCooperativeKernel((const void*)mega_fwd, dim3(grid), dim3(512), args, LDS_BYTES, stream);
    if (e != hipSuccess) fprintf(stderr, "cooperative launch failed: %s (grid %d)\n", hipGetErrorString(e), grid);
}
```

```cpp
#include <hip/hip_runtime.h>
#include <hip/hip_cooperative_groups.h>
#include <cstdio>
#include <cstdint>
namespace cg = cooperative_groups;
namespace pg8 {
#define PG8_LAS __attribute__((address_space(3)))
typedef unsigned short bf16_t;
typedef short bf16x8 __attribute__((ext_vector_type(8)));
typedef float f32x4 __attribute__((ext_vector_type(4)));
typedef unsigned u32x4 __attribute__((ext_vector_type(4)));
constexpr int BM = 256, BK = 64, HALF = 128, HTB = HALF * BK * 2  , STAGE_BYTES = 8 * HTB, NXCD = 8, WGM = 4;

__host__ __device__ __forceinline__ int lds_byte(int r, int c) { const int st = (r >> 4) * 2 + (c >> 5), rr = r & 15, cc = c & 31, ob = rr * 64 + cc * 2; return st * 1024 + (ob ^ (((ob >> 9) & 1) << 5)); }
__host__ __device__ __forceinline__ void stage_rc(int b, int& R, int& C) { const int st = b / 1024, sb = b % 1024, swz = sb ^ (((sb >> 9) & 1) << 5); R = (st >> 1) * 16 + swz / 64; C = (st & 1) * 32 + (swz % 64) / 2; }
__host__ __device__ __forceinline__ int perm32(int rho) { const int n = rho >> 4, i = rho & 15; return 8 * (i >> 2) + 4 * n + (i & 3); }

struct Unit { int pm, pn; };
struct Gemm { const bf16_t* A; const bf16_t* Bt; int M, N, K; };

struct StaticOrder {
    int nM, nN, nwg, G, c;
    __host__ __device__ void init(int M, int N, int G_, int c_) { nM = M / BM; nN = N / BM; nwg = nM * nN; G = G_; c = c_; }
    __host__ __device__ bool next(int i, Unit& u) const {
        const long L = (long)i * G + c; if (L >= nwg) return false;
        int wgid = (int)L; { const int q = nwg / NXCD, r = nwg % NXCD, xcd = wgid % NXCD, off = wgid / NXCD; wgid = (xcd < r ? xcd * (q + 1) : r * (q + 1) + (xcd - r) * q) + off; }
        const int nig = WGM * nN, gid = wgid / nig, fm = gid * WGM, gsz = (nM - fm) < WGM ? (nM - fm) : WGM;
        u.pm = fm + ((wgid % nig) % gsz); u.pn = (wgid % nig) / gsz; return true;
    }
    __device__ __forceinline__ void a_ready(const Unit&) const {}
    __device__ __forceinline__ void done(const Unit&) const {}
};
__device__ __forceinline__ unsigned cvt_pk_bf16(float lo, float hi) { unsigned r; asm volatile("v_cvt_pk_bf16_f32 %0, %1, %2" : "=v"(r) : "v"(lo), "v"(hi)); return r; }
typedef float f32x2 __attribute__((ext_vector_type(2)));
__device__ __forceinline__ f32x2 gelu_pk(f32x2 v) {
    const f32x2 av = __builtin_elementwise_abs(v), d = av * 0.2316418882f + 1.0f;
    f32x2 t; t.x = __builtin_amdgcn_rcpf(d.x); t.y = __builtin_amdgcn_rcpf(d.y);
    f32x2 q = t * 0.5307027145f + (-0.7265760135f); q = q * t + 0.7107068705f; q = q * t + (-0.142248368f); q = q * t + 0.127414796f; q = q * t;
    const f32x2 s = (v * v) * (-0.72134752044f);
    f32x2 e; e.x = __builtin_amdgcn_exp2f(s.x); e.y = __builtin_amdgcn_exp2f(s.y);
    const f32x2 m = v * (q * e), r = v - m;
    f32x2 o; o.x = v.x < 0.f ? m.x : r.x; o.y = v.y < 0.f ? m.y : r.y; return o;
}
template <class Epi, class Sched, bool STAMP = false>
__device__ __forceinline__ void gemm_phase(PG8_LAS unsigned char* lds, const Gemm g, const Sched& S, const Epi& E, unsigned long long* stamps, const int wv) {
    int tid = wv * 64 + (int)__lane_id(); asm volatile("" : "+v"(tid)); const int wid = __builtin_amdgcn_readfirstlane(tid >> 6), lane = tid & 63, wr = wid >> 2, wc = wid & 3, fr = lane & 15, fq = lane >> 4;
    const int K = g.K, nt = K / BK;
    int ts_lo = 0, ts_hi = 0, nts = 0; const unsigned long long rt_entry = STAMP ? (unsigned long long)wall_clock64() : 0ull;
#define PG8_STAMP() do { if (STAMP && wid == 0 && nts < 64) { const unsigned long long _c = (unsigned long long)clock64(); \
        ts_lo = (lane == nts) ? (int)(unsigned)_c : ts_lo; ts_hi = (lane == nts) ? (int)(unsigned)(_c >> 32) : ts_hi; ++nts; } } while (0)
    PG8_STAMP();
    unsigned voffA[2], voffB[2];
#pragma unroll
    for (int i = 0; i < 2; ++i) { int R, C; stage_rc(tid * 16 + i * 8192, R, C); const int Rb = Epi::PERM ? ((R & ~31) + perm32(R & 31)) : R;
        voffA[i] = (unsigned)(R * K + C) * 2u; voffB[i] = (unsigned)(Rb * K + C) * 2u; }
    const size_t kstep = (size_t)(BK * 2);
    const size_t hstep = (size_t)HALF * K * 2;
    const size_t tstep = 2 * hstep;
    const unsigned ldsw = (unsigned)wid * 1024u;
    const int aoff = lds_byte(wr * 64 + fr, fq * 8), boff = lds_byte(wc * 32 + fr, fq * 8);
#define PG8_SA(b, h) (((b) * 2 + (h)) * HTB)
#define PG8_SB(b, h) ((4 + (b) * 2 + (h)) * HTB)
#define PG8_STAGE(bufoff, gbase, voff) do { _Pragma("unroll") for (int _i = 0; _i < 2; ++_i) \
        __builtin_amdgcn_global_load_lds((const unsigned*)((const char*)(gbase) + (voff)[_i]), (PG8_LAS unsigned*)(lds + (bufoff) + ldsw + _i * 8192), 16, 0, 0); } while (0)
#define PG8_LDA(dst, b, h) do { _Pragma("unroll") for (int m = 0; m < 4; ++m) _Pragma("unroll") for (int k = 0; k < 2; ++k) dst[m][k] = *(const PG8_LAS bf16x8*)(lds + PG8_SA(b, h) + aoff + m * 2048 + k * 1024); } while (0)
#define PG8_LDB(dst, b, h) do { _Pragma("unroll") for (int n = 0; n < 2; ++n) _Pragma("unroll") for (int k = 0; k < 2; ++k) dst[n][k] = *(const PG8_LAS bf16x8*)(lds + PG8_SB(b, h) + boff + n * 2048 + k * 1024); } while (0)
#define PG8_MMA(ai, bj, At, Bt) do { __builtin_amdgcn_s_setprio(1); _Pragma("unroll") for (int m = 0; m < 4; ++m) _Pragma("unroll") for (int n = 0; n < 2; ++n) _Pragma("unroll") for (int k = 0; k < 2; ++k) \
        acc[ai][bj][m][n] = __builtin_amdgcn_mfma_f32_16x16x32_bf16(Bt[n][k], At[m][k], acc[ai][bj][m][n], 0, 0, 0); __builtin_amdgcn_s_setprio(0); } while (0)
#define PG8_WAIT_V(n) asm volatile("s_waitcnt vmcnt(" #n ")" ::: "memory")
#define PG8_WAIT_L(n) asm volatile("s_waitcnt lgkmcnt(" #n ")" ::: "memory")
#define PG8_BAR __builtin_amdgcn_s_barrier()
#define PG8_SCHED __builtin_amdgcn_sched_barrier(0)
    Unit cur, nxt; int ui = 0;
    if (!S.next(0, cur)) return;
    f32x4 acc[2][2][4][2];
#pragma unroll
    for (int a = 0; a < 2; ++a)
#pragma unroll
        for (int b = 0; b < 2; ++b)
#pragma unroll
            for (int m = 0; m < 4; ++m)
#pragma unroll
                for (int n = 0; n < 2; ++n) acc[a][b][m][n] = (f32x4){0.f, 0.f, 0.f, 0.f};
    bf16x8 At[4][2], B0[2][2], B1[2][2];
    const char* cA = (const char*)g.A + (size_t)cur.pm * tstep; const char* cB = (const char*)g.Bt + (size_t)cur.pn * tstep;
    S.a_ready(cur);
    PG8_STAGE(PG8_SB(0, 0), cB, voffB); PG8_STAGE(PG8_SA(0, 0), cA, voffA); PG8_STAGE(PG8_SB(0, 1), cB + hstep, voffB); PG8_STAGE(PG8_SA(0, 1), cA + hstep, voffA);
    if (wr == 1) PG8_BAR;
    PG8_WAIT_V(4); PG8_BAR;
    PG8_STAGE(PG8_SB(1, 0), cB + kstep, voffB); PG8_STAGE(PG8_SA(1, 0), cA + kstep, voffA); PG8_STAGE(PG8_SB(1, 1), cB + hstep + kstep, voffB);
    PG8_WAIT_V(6); PG8_BAR;
    PG8_STAMP();
    for (;;) {
        const bool has_next = S.next(ui + 1, nxt);
        const char* nA = has_next ? (const char*)g.A + (size_t)nxt.pm * tstep : cA; const char* nB = has_next ? (const char*)g.Bt + (size_t)nxt.pn * tstep : cB;
        for (int t = 0; t < nt; t += 2) {
            const bool last = (t == nt - 2);
            const char* a1 = cA + (size_t)(t + 1) * kstep;
            const char* a2 = last ? nA : cA + (size_t)(t + 2) * kstep; const char* b2 = last ? nB : cB + (size_t)(t + 2) * kstep;
            const char* a3 = a2 + kstep; const char* b3 = b2 + kstep;
            if (last && has_next) S.a_ready(nxt);
            PG8_LDB(B0, 0, 0); PG8_SCHED; PG8_LDA(At, 0, 0); PG8_STAGE(PG8_SA(1, 1), a1 + hstep, voffA);
            PG8_WAIT_L(8); PG8_BAR; PG8_WAIT_L(0); PG8_MMA(0, 0, At, B0); PG8_BAR; PG8_SCHED;
            PG8_LDB(B1, 0, 1); PG8_STAGE(PG8_SB(0, 0), b2, voffB);
            PG8_BAR; PG8_WAIT_L(0); PG8_MMA(0, 1, At, B1); PG8_BAR;
            PG8_LDA(At, 0, 1); PG8_STAGE(PG8_SA(0, 0), a2, voffA);
            PG8_BAR; PG8_WAIT_L(0); PG8_MMA(1, 0, At, B0); PG8_BAR; PG8_SCHED;
            PG8_STAGE(PG8_SB(0, 1), b2 + hstep, voffB);
            PG8_WAIT_V(6); PG8_BAR; PG8_MMA(1, 1, At, B1); PG8_BAR;
            PG8_LDB(B0, 1, 0); PG8_SCHED; PG8_LDA(At, 1, 0); PG8_STAGE(PG8_SA(0, 1), a2 + hstep, voffA);
            PG8_WAIT_L(8); PG8_BAR; PG8_WAIT_L(0); PG8_MMA(0, 0, At, B0); PG8_BAR; PG8_SCHED;
            PG8_LDB(B1, 1, 1); PG8_STAGE(PG8_SB(1, 0), b3, voffB);
            PG8_BAR; PG8_WAIT_L(0); PG8_MMA(0, 1, At, B1); PG8_BAR;
            PG8_LDA(At, 1, 1); PG8_STAGE(PG8_SA(1, 0), a3, voffA);
            PG8_BAR; PG8_WAIT_L(0); PG8_MMA(1, 0, At, B0); PG8_BAR; PG8_SCHED;
            PG8_STAGE(PG8_SB(1, 1), b3 + hstep, voffB);
            PG8_WAIT_V(6); PG8_BAR; PG8_MMA(1, 1, At, B1); PG8_BAR;
        }
        PG8_STAMP();
        if constexpr (!Epi::AFTER_DRAIN) { E(acc, cur, wr, wc, fr, fq); S.done(cur); }
        PG8_STAMP();
        if (!has_next) break;
#pragma unroll
        for (int a = 0; a < 2; ++a)
#pragma unroll
            for (int b = 0; b < 2; ++b)
#pragma unroll
                for (int m = 0; m < 4; ++m)
#pragma unroll
                    for (int n = 0; n < 2; ++n) acc[a][b][m][n] = (f32x4){0.f, 0.f, 0.f, 0.f};
        cur = nxt; cA = nA; cB = nB; ++ui;
    }
    PG8_WAIT_V(0);
    if (wr == 0) PG8_BAR;
    PG8_BAR;
    if constexpr (Epi::AFTER_DRAIN) { E.fused(acc, cur, wr, wc, fr, fq, lds, wid, lane); S.done(cur); }
    PG8_STAMP();
    if (STAMP && wid == 0) { stamps[lane] = lane < nts ? (((unsigned long long)(unsigned)ts_hi << 32) | (unsigned)ts_lo) : 0ull;
        if (lane == 62) stamps[62] = rt_entry; if (lane == 63) stamps[63] = (unsigned long long)wall_clock64(); }
#undef PG8_STAMP
#undef PG8_SA
#undef PG8_SB
#undef PG8_STAGE
#undef PG8_LDA
#undef PG8_LDB
#undef PG8_MMA
#undef PG8_WAIT_V
#undef PG8_WAIT_L
#undef PG8_BAR
#undef PG8_SCHED
}
}

using pg8::bf16_t; using pg8::bf16x8; using pg8::f32x4; using pg8::u32x4; using pg8::Unit; using pg8::f32x2;
typedef unsigned short u16;
typedef float f32x16 __attribute__((ext_vector_type(16)));
typedef bf16x8 bf16x8_a4 __attribute__((aligned(4)));
typedef u32x4 u32x4_a4 __attribute__((aligned(4)));
typedef unsigned u32x2 __attribute__((ext_vector_type(2)));
#define DEVI __device__ __forceinline__
#define LAS __attribute__((address_space(3)))
#define LDS_WAIT() asm volatile("s_waitcnt lgkmcnt(0)" ::: "memory")
#define GAS __attribute__((address_space(1)))
DEVI unsigned char* launder_ws(unsigned char* p) { GAS unsigned char* g = (GAS unsigned char*)p; asm volatile("" : "+s"(g)); return (unsigned char*)g; }

#define XB_TMO      128
#define XB_XCNT(j)  (256  + 64 * (j))
#define XB_XSUB(j)  (1280 + 64 * (j))
#define XB_XGEN(j)  (2304 + 64 * (j))
#define XB_TOP      3328
#define XB_TOPGEN   3392
#define XCD_BAR_WORDS 3456
#define XB_SPIN_CAP (1u << 18)
__device__ __forceinline__ unsigned xb_ld(unsigned* p)              { return __hip_atomic_load(p, __ATOMIC_RELAXED, __HIP_MEMORY_SCOPE_AGENT); }
__device__ __forceinline__ unsigned xb_add(unsigned* p, unsigned v) { return __hip_atomic_fetch_add(p, v, __ATOMIC_RELAXED, __HIP_MEMORY_SCOPE_AGENT); }
__device__ __forceinline__ unsigned xb_xcc_id() { return (unsigned)__builtin_amdgcn_s_getreg((3 << 11) | 20) & 0xFu; }
#define XB_SPIN(cond, bar) do { unsigned _sp = 0; while (cond) { __builtin_amdgcn_s_sleep(1); \
    if ((++_sp & 255u) == 0u) { if (xb_ld(&(bar)[XB_TMO])) break; if (_sp > XB_SPIN_CAP) { atomicAdd(&(bar)[XB_TMO], 1u); break; } } } } while (0)

struct XcdBarrier {
    unsigned* bar; unsigned x;
    volatile LAS unsigned* st;
};

__device__ __forceinline__ XcdBarrier xcd_barrier_post(unsigned* bar, volatile LAS unsigned* st) {
    XcdBarrier b; b.bar = bar; b.x = xb_xcc_id(); b.st = st;
    if (threadIdx.x == 0) (void)xb_add(&bar[XB_XCNT(b.x)], 1u);
    return b;
}
__device__ __forceinline__ void xcd_barrier_complete(unsigned* bar, unsigned x, unsigned& nloc, unsigned& nx) {
    const unsigned G = gridDim.x * gridDim.y * gridDim.z;
    unsigned sum, cnt, mine, sp = 0u;
    for (;;) {
        sum = 0u; cnt = 0u; mine = 0u;
#pragma unroll
        for (unsigned j = 0; j < 16; ++j) { const unsigned c = xb_ld(&bar[XB_XCNT(j)]); sum += c; cnt += (c > 0u) ? 1u : 0u; mine = (j == x) ? c : mine; }
        if (sum == G) break;
        __builtin_amdgcn_s_sleep(1);
        if ((++sp & 255u) == 0u) { if (xb_ld(&bar[XB_TMO])) break; if (sp > XB_SPIN_CAP) { atomicAdd(&bar[XB_TMO], 1u); break; } }
    }
    nloc = mine > 0u ? mine : 1u; nx = cnt > 0u ? cnt : 1u;
}

__device__ __forceinline__ void xcd_barrier(const XcdBarrier& b, const bool leader) {
    asm volatile("s_waitcnt vmcnt(0)" ::: "memory");
    __syncthreads();
    if (leader) {
        unsigned* bar = b.bar;
        __builtin_amdgcn_s_waitcnt(0);
        unsigned nloc = b.st[0], nx = b.st[1];
        if (nloc == 0u) { xcd_barrier_complete(bar, b.x, nloc, nx); b.st[0] = nloc; b.st[1] = nx; }
        const unsigned old = xb_add(&bar[XB_XSUB(b.x)], 1u);
        const unsigned gen = old / nloc;
        if (old + 1u == (gen + 1u) * nloc) {
            __builtin_amdgcn_fence(__ATOMIC_RELEASE, "agent");
            asm volatile("s_waitcnt vmcnt(0)" ::: "memory");
            const unsigned og = xb_add(&bar[XB_TOP], 1u);
            const unsigned tg = og / nx;
            if (og + 1u == (tg + 1u) * nx) xb_add(&bar[XB_TOPGEN], 1u);
            else XB_SPIN(xb_ld(&bar[XB_TOPGEN]) == tg, bar);
            __builtin_amdgcn_fence(__ATOMIC_ACQUIRE, "agent");
            xb_add(&bar[XB_XGEN(b.x)], 1u);
            asm volatile("s_waitcnt vmcnt(0)" ::: "memory");
        } else {
            XB_SPIN(xb_ld(&bar[XB_XGEN(b.x)]) == gen, bar);
            __builtin_amdgcn_fence(__ATOMIC_ACQUIRE, "agent");
            asm volatile("s_waitcnt vmcnt(0)" ::: "memory");
        }
    }
    __syncthreads();
}

constexpr int T_ = 2048, MTOK = 65536;
constexpr float ALPHA_ = 1.41421356237f, LN_EPS_ = 1e-5f, GN_EPS_ = 64e-5f;
constexpr size_t MiB = 1u << 20;
constexpr size_t OFF_WINT = 1 * MiB, OFF_WOT = 15 * MiB, OFF_WUT = 19 * MiB, OFF_WDT = 41 * MiB, OFF_LT = 52 * MiB, OFF_MOD = 53 * MiB, OFF_GT = 55 * MiB,
                 OFF_A = 72 * MiB, OFF_B = 200 * MiB;
constexpr size_t OFF_PR = OFF_B, OFF_PH = OFF_B + 256 * MiB, OFF_UT = OFF_B + 448 * MiB, OFF_X0 = OFF_B + 512 * MiB, OFF_CONVT = OFF_B + 576 * MiB;
constexpr size_t OFF_EF = OFF_B + 256 * MiB, OFF_EB = OFF_B + 320 * MiB, OFF_AF = OFF_B + 384 * MiB, OFF_AB = OFF_B + 448 * MiB, OFF_G = OFF_B + 512 * MiB,
                 OFF_YF = OFF_B + 576 * MiB, OFF_YB = OFF_B + 640 * MiB;
constexpr size_t OFF_UA = OFF_B, OFF_UG = OFF_B + 352 * MiB;
constexpr size_t WS_NEED = OFF_B + 704 * MiB;
constexpr int GT_STRIDE = 4112;
constexpr int LT_PER_LAYER = 2 * 512 * 64 * 2 + 512 * 160;

struct Params { const float* in[36]; float* out; unsigned char* ws; };
enum { I_X = 0, I_C, I_WADA, I_BADA, I_ADAT, I_WIN, I_MUP, I_MUN, I_HCW, I_HCB, I_W0, I_WUP, I_A0, I_AUP, I_GUP, I_KK, I_KA, I_RK, I_GNW, I_GNB,
       I_FW1, I_FB1, I_FWIN, I_FBIN, I_FFREQ, I_FWOUT, I_HBIAS, I_WOUT, I_LMG, I_LMB, I_FUP, I_FCW, I_FCB, I_FDN, I_LFG, I_LFB };

DEVI u16 f2bf(float f) { unsigned u = __float_as_uint(f); u += 0x7FFFu + ((u >> 16) & 1u); return (u16)(u >> 16); }
DEVI float bf2f(unsigned b) { return __uint_as_float(b << 16); }
DEVI float bflo(unsigned w) { return __uint_as_float(w << 16); }
DEVI float bfhi(unsigned w) { return __uint_as_float(w & 0xFFFF0000u); }
DEVI unsigned pk2(float lo, float hi) { return pg8::cvt_pk_bf16(lo, hi); }
DEVI float wave_sum(float v) {
#pragma unroll
    for (int o = 1; o < 64; o <<= 1) v += __shfl_xor(v, o);
    return v;
}
DEVI float sum8(float v) { v += __shfl_xor(v, 1); v += __shfl_xor(v, 2); v += __shfl_xor(v, 4); return v; }
DEVI float sigmoidf_(float x) { return __builtin_amdgcn_rcpf(1.f + __expf(-x)); }
DEVI float tanhf_(float x) { return 1.f - 2.f * __builtin_amdgcn_rcpf(__expf(2.f * x) + 1.f); }
DEVI void unpack8(const u32x4 w, float (&o)[8]) { o[0] = bflo(w.x); o[1] = bfhi(w.x); o[2] = bflo(w.y); o[3] = bfhi(w.y); o[4] = bflo(w.z); o[5] = bfhi(w.z); o[6] = bflo(w.w); o[7] = bfhi(w.w); }
DEVI u32x4 pack8(const float (&v)[8]) { u32x4 w; w.x = pk2(v[0], v[1]); w.y = pk2(v[2], v[3]); w.z = pk2(v[4], v[5]); w.w = pk2(v[6], v[7]); return w; }
DEVI void load8f(const float* p, float (&o)[8]) { const f32x4 a = *(const f32x4*)p, b = *(const f32x4*)(p + 4); o[0] = a.x; o[1] = a.y; o[2] = a.z; o[3] = a.w; o[4] = b.x; o[5] = b.y; o[6] = b.z; o[7] = b.w; }

#define FMAC_DPP(acc_, d_, o_, N_) asm("v_fmac_f32_dpp %0, %1, %2 row_ror:" #N_ " row_mask:0xf bank_mask:0xf" : "+v"(acc_) : "v"(d_), "v"(o_))
#define MUL_DPP(dst_, d_, o_, N_) asm("v_mul_f32_dpp %0, %1, %2 row_ror:" #N_ " row_mask:0xf bank_mask:0xf" : "=v"(dst_) : "v"(d_), "v"(o_))
DEVI float red4(float x) {
    float a = x, b = x;
    asm volatile("s_nop 1\n\tv_permlane16_swap_b32 %0, %1" : "+v"(a), "+v"(b));
    const float s = a + b;
    a = s; b = s;
    asm volatile("s_nop 1\n\tv_permlane32_swap_b32 %0, %1" : "+v"(a), "+v"(b));
    return a + b;
}
DEVI float red8(float x) {
    float t;
    asm("s_nop 1\n\tv_add_f32_dpp %0, %1, %1 quad_perm:[1,0,3,2] row_mask:0xf bank_mask:0xf" : "=v"(t) : "v"(x)); x = t;
    asm("s_nop 1\n\tv_add_f32_dpp %0, %1, %1 quad_perm:[2,3,0,1] row_mask:0xf bank_mask:0xf" : "=v"(t) : "v"(x)); x = t;
    asm("s_nop 1\n\tv_add_f32_dpp %0, %1, %1 row_half_mirror row_mask:0xf bank_mask:0xf" : "=v"(t) : "v"(x));
    return t;
}
DEVI void red8x2(float& x0, float& x1) {
    asm volatile("s_nop 1\n\t"
                 "v_add_f32_dpp %0, %0, %0 quad_perm:[1,0,3,2] row_mask:0xf bank_mask:0xf\n\t"
                 "v_add_f32_dpp %1, %1, %1 quad_perm:[1,0,3,2] row_mask:0xf bank_mask:0xf\n\t"
                 "s_nop 0\n\t"
                 "v_add_f32_dpp %0, %0, %0 quad_perm:[2,3,0,1] row_mask:0xf bank_mask:0xf\n\t"
                 "v_add_f32_dpp %1, %1, %1 quad_perm:[2,3,0,1] row_mask:0xf bank_mask:0xf\n\t"
                 "s_nop 0\n\t"
                 "v_add_f32_dpp %0, %0, %0 row_half_mirror row_mask:0xf bank_mask:0xf\n\t"
                 "v_add_f32_dpp %1, %1, %1 row_half_mirror row_mask:0xf bank_mask:0xf"
                 : "+v"(x0), "+v"(x1));
}
DEVI float wave_sum_dpp(float x) {
    float t;
    asm("s_nop 1\n\tv_add_f32_dpp %0, %1, %1 row_ror:1 row_mask:0xf bank_mask:0xf" : "=v"(t) : "v"(x)); x = t;
    asm("s_nop 1\n\tv_add_f32_dpp %0, %1, %1 row_ror:2 row_mask:0xf bank_mask:0xf" : "=v"(t) : "v"(x)); x = t;
    asm("s_nop 1\n\tv_add_f32_dpp %0, %1, %1 row_ror:4 row_mask:0xf bank_mask:0xf" : "=v"(t) : "v"(x)); x = t;
    asm("s_nop 1\n\tv_add_f32_dpp %0, %1, %1 row_ror:8 row_mask:0xf bank_mask:0xf" : "=v"(t) : "v"(x)); x = t;
    return red4(x);
}

struct EpiSplitBf16 {
    static constexpr bool PERM = true, AFTER_DRAIN = false;
    u16* O0; u16* O1; int nsplit, ld0, ld1;
    __device__ __forceinline__ void operator()(const f32x4 (&acc)[2][2][4][2], const Unit& u, int wr, int wc, int fr, int fq) const {
        const int row0 = u.pm * 256 + wr * 64 + fr;
        u16* base; int ldc, colt;
        if (u.pn < nsplit) { base = O0; ldc = ld0; colt = u.pn * 256; } else { base = O1; ldc = ld1; colt = (u.pn - nsplit) * 256; }
        const int col0 = colt + wc * 32 + 8 * fq;
#pragma unroll
        for (int ai = 0; ai < 2; ++ai)
#pragma unroll
            for (int m = 0; m < 4; ++m) { u16* rowp = base + (size_t)(row0 + ai * 128 + m * 16) * ldc + col0;
#pragma unroll
                for (int bj = 0; bj < 2; ++bj) { const f32x4 v0 = acc[ai][bj][m][0], v1 = acc[ai][bj][m][1];
                    u32x4 w; w.x = pk2(v0[0], v0[1]); w.y = pk2(v0[2], v0[3]); w.z = pk2(v1[0], v1[1]); w.w = pk2(v1[2], v1[3]);
                    *(u32x4*)(rowp + bj * 128) = w; } }
    }
};
struct EpiRes {
    static constexpr bool PERM = false, AFTER_DRAIN = false;
    const float* xin; float* xout; const float* gate;
    __device__ __forceinline__ void operator()(const f32x4 (&acc)[2][2][4][2], const Unit& u, int wr, int wc, int fr, int fq) const {
        const int row0 = u.pm * 256 + wr * 64 + fr, col0 = u.pn * 256 + wc * 32 + 4 * fq;
        const float* gp = gate + (size_t)(u.pm >> 3) * 6144 + col0;
        f32x4 gv[2][2];
#pragma unroll
        for (int bj = 0; bj < 2; ++bj)
#pragma unroll
            for (int n = 0; n < 2; ++n) gv[bj][n] = *(const f32x4*)(gp + bj * 128 + n * 16) + 1.0f;
#pragma unroll
        for (int ai = 0; ai < 2; ++ai)
#pragma unroll
            for (int m = 0; m < 4; ++m) { const size_t off = (size_t)(row0 + ai * 128 + m * 16) * 1024 + col0;
#pragma unroll
                for (int bj = 0; bj < 2; ++bj)
#pragma unroll
                    for (int n = 0; n < 2; ++n) { const f32x4 xv = *(const f32x4*)(xin + off + bj * 128 + n * 16);
                        *(f32x4*)(xout + off + bj * 128 + n * 16) = xv * ALPHA_ + gv[bj][n] * acc[ai][bj][m][n]; } }
    }
};

template <class Epi> DEVI void run_gemm(LAS unsigned char* lds, const u16* A, const u16* Bt, int N, int K, const Epi& E, int wv) {
    pg8::Gemm g; g.A = A; g.Bt = Bt; g.M = MTOK; g.N = N; g.K = K;
    pg8::StaticOrder S; S.init(MTOK, N, (int)gridDim.x, (int)blockIdx.x);
    pg8::gemm_phase<Epi, pg8::StaticOrder, false>(lds, g, S, E, nullptr, wv);
}

DEVI void transpose_item(const float* W, int K, int N, u16* WT, int drow, LAS float* scr, int k0, int n0, int lane) {
#pragma unroll 8
    for (int i = 0; i < 32; ++i) { const int kk = 2 * i + (lane >> 5); scr[kk * 33 + (lane & 31)] = W[(size_t)(k0 + kk) * N + n0 + (lane & 31)]; }
    LDS_WAIT();
    const int c = lane & 7;
#pragma unroll
    for (int j = 0; j < 4; ++j) { const int n = (lane >> 3) + 8 * j; const LAS float* s = scr + (8 * c) * 33 + n;
        u32x4 o; o.x = pk2(s[0 * 33], s[1 * 33]); o.y = pk2(s[2 * 33], s[3 * 33]); o.z = pk2(s[4 * 33], s[5 * 33]); o.w = pk2(s[6 * 33], s[7 * 33]);
        *(u32x4*)(WT + (size_t)(drow + n) * K + k0 + 8 * c) = o; }
    LDS_WAIT();
}

DEVI void phase_prologue(const Params& P, LAS unsigned char* lds, int wv) {
    int tid_l = wv * 64 + (int)__lane_id(); asm volatile("" : "+v"(tid_l));
    const int tid = tid_l, lane = tid & 63, wave = tid >> 6;
    unsigned char* ws = launder_ws(P.ws);
    float* MOD = (float*)(ws + OFF_MOD);
#if defined(PROBE_VALU)
    {
        float a[16]; float z = (float)tid * 1e-3f;
#pragma unroll
        for (int i = 0; i < 16; ++i) a[i] = (float)(tid + i) * 1e-4f;
        for (int it = 0; it < PROBE_N; ++it) {
#if PROBE_VALU == 1
            FMAC_DPP(a[1], z, a[0], 1); FMAC_DPP(a[2], z, a[0], 2); FMAC_DPP(a[3], z, a[0], 3); FMAC_DPP(a[4], z, a[0], 4); FMAC_DPP(a[5], z, a[0], 5);
            FMAC_DPP(a[6], z, a[0], 6); FMAC_DPP(a[7], z, a[0], 7); FMAC_DPP(a[8], z, a[0], 8); FMAC_DPP(a[9], z, a[0], 9); FMAC_DPP(a[10], z, a[0], 10);
            FMAC_DPP(a[11], z, a[0], 11); FMAC_DPP(a[12], z, a[0], 12); FMAC_DPP(a[13], z, a[0], 13); FMAC_DPP(a[14], z, a[0], 14); FMAC_DPP(a[15], z, a[0], 15);
#else
#pragma unroll
            for (int i = 1; i < 16; ++i) asm volatile("v_fmac_f32_e32 %0, %1, %2" : "+v"(a[i]) : "v"(z), "v"(a[0]));
#endif
            asm volatile("" : "+v"(a[0]));
        }
        float sum = 0.f;
#pragma unroll
        for (int i = 0; i < 16; ++i) sum += a[i];
        if (sum == 123.456f) MOD[0] = sum;
    }
#endif
    {
        LAS float* red = (LAS float*)lds;
        const float* cin = P.in[I_C]; const float* W = P.in[I_WADA];
        const int r = lane & 31, hh = lane >> 5;
        for (int item = blockIdx.x; item < 192; item += gridDim.x) {
            const int n0 = item * 32;
            f32x16 acc;
#pragma unroll
            for (int i = 0; i < 16; ++i) acc[i] = 0.f;
#pragma unroll 16
            for (int ks = 0; ks < 64; ++ks) {
                const int k = wave * 128 + ks * 2 + hh;
                const float cv = cin[r * 1024 + k]; const float a = cv / (1.f + expf(-cv));
                const float bv = W[(size_t)k * 6144 + n0 + r];
                acc = __builtin_amdgcn_mfma_f32_32x32x2f32(a, bv, acc, 0, 0, 0);
            }
#pragma unroll
            for (int rg = 0; rg < 16; ++rg) { const int row = (rg & 3) + 8 * (rg >> 2) + 4 * hh; red[(wave * 32 + row) * 32 + r] = acc[rg]; }
            __syncthreads();
            for (int e = tid; e < 1024; e += 512) {
                const int row = e >> 5, col = e & 31; float s = 0.f;
#pragma unroll
                for (int w = 0; w < 8; ++w) s += red[(w * 32 + row) * 32 + col];
                const int n = n0 + col; s += P.in[I_BADA][n];
                const int gi = n >> 10, nn = n & 1023;
#pragma unroll
                for (int l = 0; l < 2; ++l) MOD[((size_t)(l * 32 + row) * 6 + gi) * 1024 + nn] = s + P.in[I_ADAT][(l * 6 + gi) * 1024 + nn];
            }
            __syncthreads();
        }
    }
    {
        LAS float* scr = (LAS float*)(lds + 32768) + wave * (64 * 33);
        const int gw = blockIdx.x * 8 + wave, NGW = gridDim.x * 8;
        u16* WINT = (u16*)(ws + OFF_WINT); u16* WOT = (u16*)(ws + OFF_WOT); u16* WUT = (u16*)(ws + OFF_WUT); u16* WDT = (u16*)(ws + OFF_WDT);
        for (int it = gw; it < 2 * 6480; it += NGW) {
            const int l = it / 6480; int r = it % 6480;
            if (r < 1744) { const int kb = r / 109, nb = r % 109, n0 = nb * 32, drow = n0 < 1952 ? n0 : n0 + 96;
                transpose_item(P.in[I_WIN] + (size_t)l * 1024 * 3488, 1024, 3488, WINT + (size_t)l * 3584 * 1024, drow, scr, kb * 64, n0, lane); continue; }
            r -= 1744;
            if (r < 512) { const int kb = r / 32, nb = r % 32;
                transpose_item(P.in[I_WOUT] + (size_t)l * 1024 * 1024, 1024, 1024, WOT + (size_t)l * 1024 * 1024, nb * 32, scr, kb * 64, nb * 32, lane); continue; }
            r -= 512;
            if (r < 2816) { const int kb = r / 176, nb = r % 176;
                transpose_item(P.in[I_FUP] + (size_t)l * 1024 * 5632, 1024, 5632, WUT + (size_t)l * 5632 * 1024, nb * 32, scr, kb * 64, nb * 32, lane); continue; }
            r -= 2816;
            { const int kb = r / 32, nb = r % 32;
                transpose_item(P.in[I_FDN] + (size_t)l * 2816 * 1024, 2816, 1024, WDT + (size_t)l * 1024 * 2816, nb * 32, scr, kb * 64, nb * 32, lane); }
        }
        const int gtid = blockIdx.x * 512 + tid, NT = gridDim.x * 512;
        for (int i = gtid; i < 2 * 96 * 128; i += NT) { const int l = i / (96 * 128), rr = i % (96 * 128);
            *(u32x4*)(WINT + (size_t)l * 3584 * 1024 + (size_t)1952 * 1024 + (size_t)rr * 8) = (u32x4){0u, 0u, 0u, 0u}; }
        u16* LT = (u16*)(ws + OFF_LT);
        for (int i = gtid; i < 2 * LT_PER_LAYER; i += NT) {
            const int l = i / LT_PER_LAYER; int e = i % LT_PER_LAYER; float v;
            if (e < 65536) { const int d = e >> 15, n = (e >> 6) & 511, k = e & 63; v = P.in[I_WUP][((size_t)(l * 2 + d) * 64 + k) * 512 + n]; }
            else if (e < 131072) { const int e2 = e - 65536; const int d = e2 >> 15, n = (e2 >> 6) & 511, k = e2 & 63; v = P.in[I_AUP][((size_t)(l * 2 + d) * 64 + k) * 512 + n]; }
            else { const int e2 = e - 131072; const int n = e2 / 160, k = e2 % 160; v = P.in[I_GUP][((size_t)l * 160 + k) * 512 + n]; }
            LT[i] = f2bf(e < 131072 ? v * -1.44269504089f : v);
        }
    }
    __syncthreads();
    {
        LAS float* zb = (LAS float*)lds;
        LAS float* hb0 = zb + 8 * 36;
        LAS float* hb1 = hb0 + 64 * 8;
        u16* GT = (u16*)(ws + OFF_GT);
        const int p = tid >> 6, j = tid & 63;
        for (int item = blockIdx.x; item < 512; item += gridDim.x) {
            const int l = item >> 8, i0 = (item & 255) * 8, i = i0 + p;
            const float t = (float)i * (1.0f / 2047.0f);
            if (j < 33) {
                float z;
                if (j == 0) z = t;
                else { const int bnd = (j - 1) & 15; const float f = 1e-4f + (float)bnd * ((15.0f - 1e-4f) / 15.0f);
                    const float ang = (6.283185307179586f / 2048.0f) * (float)i * f; z = (j <= 16) ? cosf(ang) : -sinf(ang); }
                zb[p * 36 + j] = z;
            }
            __syncthreads();
            const float fr = P.in[I_FFREQ][l * 64 + j];
            { float a = P.in[I_FB1][l * 64 + j]; const float* w1 = P.in[I_FW1] + (size_t)l * 33 * 64 + j;
#pragma unroll 11
                for (int m = 0; m < 33; ++m) a += zb[p * 36 + m] * w1[m * 64];
                hb0[j * 8 + p] = sinf(fr * a); }
            __syncthreads();
            { float a = P.in[I_FBIN][(l * 2 + 0) * 64 + j]; const float* w = P.in[I_FWIN] + (size_t)(l * 2 + 0) * 4096 + j;
#pragma unroll 16
                for (int m = 0; m < 64; ++m) a += hb0[m * 8 + p] * w[m * 64];
                hb1[j * 8 + p] = sinf(fr * a); }
            __syncthreads();
            { float a = P.in[I_FBIN][(l * 2 + 1) * 64 + j]; const float* w = P.in[I_FWIN] + (size_t)(l * 2 + 1) * 4096 + j;
#pragma unroll 16
                for (int m = 0; m < 64; ++m) a += hb1[m * 8 + p] * w[m * 64];
                a = sinf(fr * a);
                __syncthreads();
                hb0[j * 8 + p] = a; }
            __syncthreads();
#pragma unroll
            for (int qq = 0; qq < 2; ++qq) {
                const int n = j + 64 * (p + 8 * qq);
                float acc8[8];
#pragma unroll
                for (int pp = 0; pp < 8; ++pp) acc8[pp] = 0.f;
                const float* wo = P.in[I_FWOUT] + (size_t)l * 64 * 1024 + n;
#pragma unroll 16
                for (int m = 0; m < 64; ++m) { const float w = wo[m * 1024]; const f32x4 h0 = *(const LAS f32x4*)(hb0 + m * 8), h1 = *(const LAS f32x4*)(hb0 + m * 8 + 4);
                    acc8[0] += h0.x * w; acc8[1] += h0.y * w; acc8[2] += h0.z * w; acc8[3] += h0.w * w; acc8[4] += h1.x * w; acc8[5] += h1.y * w; acc8[6] += h1.z * w; acc8[7] += h1.w * w; }
                const int c = n & 511;
                const float dl = fabsf(-3.0701134573f + (float)c * ((-15.3505672866f + 3.0701134573f) / 511.0f));
                u16* g0 = GT + ((size_t)(l * 512 + c) * 2) * GT_STRIDE; u16* g1 = g0 + GT_STRIDE;
#pragma unroll
                for (int pp = 0; pp < 8; ++pp) {
                    const int ii = i0 + pp; const float tt = (float)ii * (1.0f / 2047.0f);
                    float val = acc8[pp] * expf(-tt * dl);
                    int idx;
                    if (n < 512) { idx = 2048 - ii; if (ii == 0) val += P.in[I_HBIAS][l * 512 + c]; } else { idx = 2048 + ii; }
                    if (n < 512 || ii > 0) { const u16 hv = f2bf(val); g0[idx] = hv; g1[idx - 1] = hv; }
                }
            }
            __syncthreads();
        }
    }
}

template <int MODE> DEVI void phase_ln(const float* xin, const u16* mix, const float* gate, float* dst, const float* g, const float* bta, const float* modsh, const float* modsc, u16* H, int wv) {
    int tid_l = wv * 64 + (int)__lane_id(); asm volatile("" : "+v"(tid_l));
    const int lane = tid_l & 63, wave = tid_l >> 6;
    const int gw = blockIdx.x * 8 + wave, NGW = gridDim.x * 8;
    constexpr int R = 2;
    for (int row0 = gw * R; row0 < MTOK; row0 += NGW * R) {
        const int b = row0 >> 11;
        f32x4 v[R][4]; float s[R], s2[R], mean[R], rstd[R];
#pragma unroll
        for (int r = 0; r < R; ++r) { const f32x4* xr = (const f32x4*)(xin + (size_t)(row0 + r) * 1024) + lane;
#pragma unroll
            for (int j = 0; j < 4; ++j) v[r][j] = __builtin_nontemporal_load(xr + 64 * j); }
        if (MODE >= 1) {
            u32x2 mr[R][4];
#pragma unroll
            for (int r = 0; r < R; ++r) { const u32x2* mp = (const u32x2*)(mix + (size_t)(row0 + r) * 1024) + lane;
#pragma unroll
                for (int j = 0; j < 4; ++j) mr[r][j] = __builtin_nontemporal_load(mp + 64 * j); }
            const f32x4* gp = (const f32x4*)(gate + (size_t)b * 6144) + lane;
#pragma unroll
            for (int j = 0; j < 4; ++j) { const f32x4 gv = gp[64 * j] + 1.0f;
#pragma unroll
                for (int r = 0; r < R; ++r) { const f32x4 mv = (f32x4){bflo(mr[r][j].x), bfhi(mr[r][j].x), bflo(mr[r][j].y), bfhi(mr[r][j].y)};
                    v[r][j] = v[r][j] * ALPHA_ + gv * mv; } }
        }
#pragma unroll
        for (int r = 0; r < R; ++r) { s[r] = 0.f;
#pragma unroll
            for (int j = 0; j < 4; ++j) s[r] += (v[r][j].x + v[r][j].y) + (v[r][j].z + v[r][j].w); }
#pragma unroll
        for (int r = 0; r < R; ++r) mean[r] = wave_sum_dpp(s[r]) * (1.f / 1024.f);
#pragma unroll
        for (int r = 0; r < R; ++r) { s2[r] = 0.f;
#pragma unroll
            for (int j = 0; j < 4; ++j) { v[r][j] = v[r][j] - mean[r]; s2[r] += (v[r][j].x * v[r][j].x + v[r][j].y * v[r][j].y) + (v[r][j].z * v[r][j].z + v[r][j].w * v[r][j].w); } }
#pragma unroll
        for (int r = 0; r < R; ++r) rstd[r] = 1.f / sqrtf(wave_sum_dpp(s2[r]) * (1.f / 1024.f) + LN_EPS_);
        if (MODE >= 1) {
#pragma unroll
            for (int j = 0; j < 4; ++j) { const f32x4 gg = *((const f32x4*)g + lane + 64 * j), bb = *((const f32x4*)bta + lane + 64 * j);
#pragma unroll
                for (int r = 0; r < R; ++r) { v[r][j] = v[r][j] * rstd[r] * gg + bb; __builtin_nontemporal_store(v[r][j], (f32x4*)(dst + (size_t)(row0 + r) * 1024) + lane + 64 * j); } }
            if (MODE == 1) {
#pragma unroll
                for (int r = 0; r < R; ++r) { s[r] = 0.f;
#pragma unroll
                    for (int j = 0; j < 4; ++j) s[r] += (v[r][j].x + v[r][j].y) + (v[r][j].z + v[r][j].w); }
#pragma unroll
                for (int r = 0; r < R; ++r) mean[r] = wave_sum_dpp(s[r]) * (1.f / 1024.f);
#pragma unroll
                for (int r = 0; r < R; ++r) { s2[r] = 0.f;
#pragma unroll
                    for (int j = 0; j < 4; ++j) { v[r][j] = v[r][j] - mean[r]; s2[r] += (v[r][j].x * v[r][j].x + v[r][j].y * v[r][j].y) + (v[r][j].z * v[r][j].z + v[r][j].w * v[r][j].w); } }
#pragma unroll
                for (int r = 0; r < R; ++r) rstd[r] = 1.f / sqrtf(wave_sum_dpp(s2[r]) * (1.f / 1024.f) + LN_EPS_);
            }
        }
        if (MODE <= 1) {
            const f32x4* sh = (const f32x4*)(modsh + (size_t)b * 6144) + lane; const f32x4* sc = (const f32x4*)(modsc + (size_t)b * 6144) + lane;
#pragma unroll
            for (int j = 0; j < 4; ++j) { const f32x4 scv = sc[64 * j] + 1.0f, shv = sh[64 * j];
#pragma unroll
                for (int r = 0; r < R; ++r) { const f32x4 y = v[r][j] * rstd[r] * scv + shv;
                    __builtin_nontemporal_store((unsigned long long)pk2(y.x, y.y) | ((unsigned long long)pk2(y.z, y.w) << 32), (unsigned long long*)(H + (size_t)(row0 + r) * 1024) + lane + 64 * j); } }
        }
    }
}

DEVI void phase_hy_prep(const Params& P, int l, LAS unsigned char* lds, int wv) {
    int tid_l = wv * 64 + (int)__lane_id(); asm volatile("" : "+v"(tid_l));
    unsigned char* ws = launder_ws(P.ws); asm volatile("" : "+s"(l));
    const u16* PH = (const u16*)(ws + OFF_PH); u16* UT = (u16*)(ws + OFF_UT); u16* X0 = (u16*)(ws + OFF_X0);
    const int tsub = tid_l >> 6, c8 = (tid_l & 63) * 8;
    for (int item = blockIdx.x; item < 1024; item += gridDim.x) {
        const int b = item >> 5, t0 = (item & 31) * 64 + tsub * 8;
        const u16* base = PH + ((size_t)b * T_ + t0) * 1536 + c8;
        const bool hp = t0 > 0, hn = (t0 + 8) < T_;
        float u[8][8];
#pragma unroll
        for (int i = 0; i < 3; ++i) {
            float w0[8], w1[8], w2[8], bs[8];
            load8f(P.in[I_HCW] + ((size_t)l * 3 + 0) * 1536 + i * 512 + c8, w0); load8f(P.in[I_HCW] + ((size_t)l * 3 + 1) * 1536 + i * 512 + c8, w1);
            load8f(P.in[I_HCW] + ((size_t)l * 3 + 2) * 1536 + i * 512 + c8, w2); load8f(P.in[I_HCB] + (size_t)l * 1536 + i * 512 + c8, bs);
            u32x4 raw[10];
            raw[0] = *(const u32x4*)(hp ? base - 1536 + i * 512 : base + i * 512);
#pragma unroll
            for (int r = 0; r < 8; ++r) raw[r + 1] = *(const u32x4*)(base + (size_t)r * 1536 + i * 512);
            raw[9] = *(const u32x4*)(hn ? base + (size_t)8 * 1536 + i * 512 : base + i * 512);
            float prev[8], cur[8], nxt[8];
            unpack8(raw[0], prev); unpack8(raw[1], cur);
            if (!hp) {
#pragma unroll
                for (int j = 0; j < 8; ++j) prev[j] = 0.f; }
#pragma unroll
            for (int r = 0; r < 8; ++r) {
                unpack8(raw[r + 2], nxt);
                if (r == 7 && !hn) {
#pragma unroll
                    for (int j = 0; j < 8; ++j) nxt[j] = 0.f; }
                float q[8];
#pragma unroll
                for (int j = 0; j < 8; ++j) { q[j] = w0[j] * prev[j] + w1[j] * cur[j] + w2[j] * nxt[j] + bs[j]; prev[j] = cur[j]; cur[j] = nxt[j]; }
                if (i == 0) *(u32x4*)(X0 + ((size_t)b * T_ + t0 + r) * 512 + c8) = pack8(q);
                else if (i == 1) {
#pragma unroll
                    for (int j = 0; j < 8; ++j) u[r][j] = q[j]; }
                else {
#pragma unroll
                    for (int j = 0; j < 8; ++j) u[r][j] *= q[j]; }
            }
        }
#pragma unroll
        for (int j = 0; j < 8; ++j) { const float col[8] = {u[0][j], u[1][j], u[2][j], u[3][j], u[4][j], u[5][j], u[6][j], u[7][j]};
            *(u32x4*)(UT + ((size_t)(c8 + j) * 32 + b) * T_ + t0) = pack8(col); }
    }
}

DEVI void phase_hy_conv(const Params& P, int l, int wv) {
    int tid_l = wv * 64 + (int)__lane_id(); asm volatile("" : "+v"(tid_l));
    unsigned char* ws = launder_ws(P.ws); asm volatile("" : "+s"(l));
    const int lane = tid_l & 63, wave = __builtin_amdgcn_readfirstlane(tid_l >> 6), r = lane & 31, hh = lane >> 5;
    const u16* GT = (const u16*)(ws + OFF_GT); const u16* UT = (const u16*)(ws + OFF_UT); u16* CONVT = (u16*)(ws + OFF_CONVT);
    const int lanebase = 2048 + 8 * hh - r - 256 * wave;
    const int par = lanebase & 1;
    const unsigned goff = (unsigned)((par * GT_STRIDE + lanebase - par) * 2);
    const unsigned uoff = (unsigned)((r * T_ + 8 * hh) * 2), soff = (unsigned)((r * T_ + 4 * hh) * 2);
    for (int c = blockIdx.x; c < 512; c += gridDim.x) {
        const char* gts = (const char*)(GT + ((size_t)(l * 512 + c) * 2) * GT_STRIDE) - 512;
        const char* utb = (const char*)(UT + (size_t)c * 32 * T_);
        f32x16 acc[8];
#pragma unroll
        for (int m = 0; m < 8; ++m)
#pragma unroll
            for (int i = 0; i < 16; ++i) acc[m][i] = 0.f;
        bf16x8 W[16];
#define HY_LOADF(gb_, e16_) (*(const bf16x8_a4*)((gb_) + goff + 32 * (e16_)))
#define HY_LOADB(ub_, j_) (*(const bf16x8*)((ub_) + uoff + 32 * (j_)))
#pragma unroll
        for (int u = 0; u < 16; ++u) W[u] = (bf16x8){0, 0, 0, 0, 0, 0, 0, 0};
#pragma unroll
        for (int u = 2; u < 16; ++u) W[u] = HY_LOADF(gts, u);
        bf16x8 wn0 = HY_LOADF(gts, 16), wn1 = HY_LOADF(gts, 17);
        bf16x8 bn0 = HY_LOADB(utb, 0), bn1 = HY_LOADB(utb, 1);
        for (int jj = 0; jj < 8; ++jj) {
            const char* gj = gts + 512 * jj; const char* uj = utb + 512 * jj;
#pragma unroll
            for (int u = 0; u < 16; ++u) {
                bf16x8 bfr;
                if ((u & 1) == 0) { W[u] = wn0; bfr = bn0; wn0 = HY_LOADF(gj, u + 18); bn0 = HY_LOADB(uj, u + 2); }
                else { W[u] = wn1; bfr = bn1; wn1 = HY_LOADF(gj, u + 18); bn1 = HY_LOADB(uj, u + 2); }
#pragma unroll
                for (int m = 0; m < 8; ++m) acc[m] = __builtin_amdgcn_mfma_f32_32x32x16_bf16(W[(u - 2 * m) & 15], bfr, acc[m], 0, 0, 0);
            }
        }
#undef HY_LOADF
#undef HY_LOADB
        char* cb = (char*)(CONVT + (size_t)c * 32 * T_) + 512 * wave;
#pragma unroll
        for (int m = 0; m < 8; ++m) {
#pragma unroll
            for (int q = 0; q < 4; ++q) { u32x2 o; o.x = pk2(acc[m][4 * q], acc[m][4 * q + 1]); o.y = pk2(acc[m][4 * q + 2], acc[m][4 * q + 3]);
                *(u32x2*)(cb + soff + (64 * m + 16 * q)) = o; } }
    }
}

DEVI void phase_hy_post(const Params& P, LAS unsigned char* lds, int wv) {
    int tid_l = wv * 64 + (int)__lane_id(); asm volatile("" : "+v"(tid_l));
    unsigned char* ws = launder_ws(P.ws);
    const u16* CONVT = (const u16*)(ws + OFF_CONVT); const u16* X0 = (const u16*)(ws + OFF_X0); u16* YM = (u16*)(ws + OFF_A);
    const int tsub = tid_l >> 6, c8 = (tid_l & 63) * 8;
    for (int item = blockIdx.x; item < 1024; item += gridDim.x) {
        const int b = item >> 5, t0 = (item & 31) * 64 + tsub * 8;
        u32x4 cv[8], xv[8];
#pragma unroll
        for (int j = 0; j < 8; ++j) cv[j] = __builtin_nontemporal_load((const u32x4*)(CONVT + ((size_t)(c8 + j) * 32 + b) * T_ + t0));
#pragma unroll
        for (int r = 0; r < 8; ++r) xv[r] = __builtin_nontemporal_load((const u32x4*)(X0 + ((size_t)b * T_ + t0 + r) * 512 + c8));
        float cf[8][8];
#pragma unroll
        for (int j = 0; j < 8; ++j) unpack8(cv[j], cf[j]);
#pragma unroll
        for (int r = 0; r < 8; ++r) { float x[8], o[8]; unpack8(xv[r], x);
#pragma unroll
            for (int j = 0; j < 8; ++j) o[j] = x[j] * cf[j][r];
            *(u32x4*)(YM + ((size_t)b * T_ + t0 + r) * 1024 + 512 + c8) = pack8(o); }
    }
}

DEVI void phase_rwkv_prep(const Params& P, int l, int wv) {
    int tid_l = wv * 64 + (int)__lane_id(); asm volatile("" : "+v"(tid_l));
    unsigned char* ws = launder_ws(P.ws); asm volatile("" : "+s"(l));
    const int lane = tid_l & 63, wave = tid_l >> 6, r = lane & 31, hh = lane >> 5;
    const int gw = blockIdx.x * 8 + wave, NGW = gridDim.x * 8;
    const u16* PR = (const u16*)(ws + OFF_PR);
    const u16* LT = (const u16*)(ws + OFF_LT) + (size_t)l * LT_PER_LAYER;
    const float* mup = P.in[I_MUP] + l * 1952; const float* mun = P.in[I_MUN] + l * 1952;
    for (int it = gw; it < 2048 * 5; it += NGW) {
        const int mat = it % 5, tok0 = (it / 5) * 32, tok = tok0 + r, t = tok & 2047;
        const int K = (mat == 4) ? 160 : 64, cbase = (mat == 4) ? 1792 : 1536 + 64 * mat;
        const u16* pr = PR + (size_t)tok * 2048 + cbase + 8 * hh;
        bf16x8 af[10];
#pragma unroll
        for (int kk = 0; kk < 10; ++kk) {
            af[kk] = (bf16x8){0, 0, 0, 0, 0, 0, 0, 0};
            if (kk * 16 < K) {
                float pc[8], pp[8], pn[8], mp[8], mn[8], x[8];
                unpack8(*(const u32x4*)(pr + kk * 16), pc);
                if (t > 0) unpack8(*(const u32x4*)(pr + kk * 16 - 2048), pp); else {
#pragma unroll
                    for (int q = 0; q < 8; ++q) pp[q] = 0.f; }
                if (t < T_ - 1) unpack8(*(const u32x4*)(pr + kk * 16 + 2048), pn); else {
#pragma unroll
                    for (int q = 0; q < 8; ++q) pn[q] = 0.f; }
                load8f(mup + cbase + 8 * hh + kk * 16, mp); load8f(mun + cbase + 8 * hh + kk * 16, mn);
#pragma unroll
                for (int q = 0; q < 8; ++q) { float v = pc[q] + mp[q] * (pp[q] - pc[q]) + mn[q] * (pn[q] - pc[q]);
                    if (mat < 2) v = tanhf_(v); else if (mat == 4) v = sigmoidf_(v);
                    x[q] = v; }
                const u32x4 pk = pack8(x);
                af[kk] = __builtin_bit_cast(bf16x8, pk);
            }
        }
        const u16* lt = (mat < 2) ? LT + (size_t)mat * 32768 : (mat < 4) ? LT + 65536 + (size_t)(mat - 2) * 32768 : LT + 131072;
        const float* bias = (mat < 2) ? P.in[I_W0] + (size_t)(l * 2 + mat) * 512 : P.in[I_A0] + (size_t)(l * 2 + (mat & 1)) * 512;
        u16* outp = (u16*)(ws + (mat == 0 ? OFF_EF : mat == 1 ? OFF_EB : mat == 2 ? OFF_AF : mat == 3 ? OFF_AB : OFF_G));
#define GLOAD16(dst_, ptr_) asm volatile("global_load_dwordx4 %0, %1, off" : "=v"(dst_) : "v"(ptr_) : "memory")
        u32x4 fn[10], fc[10]; f32x4 bn[4], bc[4];
#pragma unroll
        for (int kk = 0; kk < 10; ++kk) { fn[kk] = (u32x4){0u, 0u, 0u, 0u}; fc[kk] = fn[kk]; }
#pragma unroll
        for (int q = 0; q < 4; ++q) { bn[q] = (f32x4){0.f, 0.f, 0.f, 0.f}; bc[q] = bn[q]; }
        { const u16* bp = lt + (size_t)r * K + 8 * hh;
#pragma unroll
          for (int kk = 0; kk < 10; ++kk) if (kk * 16 < K) GLOAD16(fn[kk], bp + kk * 16);
          if (mat < 4) {
#pragma unroll
              for (int q = 0; q < 4; ++q) GLOAD16(bn[q], bias + 8 * q + 4 * hh); } }
        asm volatile("s_waitcnt vmcnt(0)" ::: "memory");
        for (int nt = 0; nt < 16; ++nt) {
#pragma unroll
            for (int kk = 0; kk < 10; ++kk) fc[kk] = fn[kk];
#pragma unroll
            for (int q = 0; q < 4; ++q) bc[q] = bn[q];
            asm volatile("" ::: "memory");
            if (nt + 1 < 16) { const u16* bp = lt + (size_t)((nt + 1) * 32 + r) * K + 8 * hh;
#pragma unroll
                for (int kk = 0; kk < 10; ++kk) if (kk * 16 < K) GLOAD16(fn[kk], bp + kk * 16);
                if (mat < 4) {
#pragma unroll
                    for (int q = 0; q < 4; ++q) GLOAD16(bn[q], bias + (nt + 1) * 32 + 8 * q + 4 * hh); } }
            f32x16 acc;
#pragma unroll
            for (int q = 0; q < 4; ++q)
#pragma unroll
                for (int e = 0; e < 4; ++e) acc[4 * q + e] = bc[q][e] * -1.44269504089f;
#pragma unroll
            for (int kk = 0; kk < 10; ++kk) if (kk * 16 < K) acc = __builtin_amdgcn_mfma_f32_32x32x16_bf16(__builtin_bit_cast(bf16x8, fc[kk]), af[kk], acc, 0, 0, 0);
            unsigned pkd[4][2];
#pragma unroll
            for (int q = 0; q < 4; ++q) {
                float o[4];
#pragma unroll
                for (int e = 0; e < 4; ++e) { const float x = acc[4 * q + e]; o[e] = (mat < 4) ? __builtin_amdgcn_rcpf(1.f + __builtin_amdgcn_exp2f(x)) : x; }
                pkd[q][0] = pk2(o[0], o[1]); pkd[q][1] = pk2(o[2], o[3]);
            }
#pragma unroll
            for (int p = 0; p < 2; ++p) {
                asm volatile("s_nop 1\n\tv_permlane32_swap_b32 %0, %1" : "+v"(pkd[2 * p][0]), "+v"(pkd[2 * p + 1][0]));
                asm volatile("s_nop 1\n\tv_permlane32_swap_b32 %0, %1" : "+v"(pkd[2 * p][1]), "+v"(pkd[2 * p + 1][1]));
                u32x4 w; w.x = pkd[2 * p][0]; w.y = pkd[2 * p][1]; w.z = pkd[2 * p + 1][0]; w.w = pkd[2 * p + 1][1];
                *(u32x4*)(outp + (size_t)(tok0 + r) * 512 + nt * 32 + 16 * p + 8 * hh) = w;
            }
            asm volatile("s_waitcnt vmcnt(2)" ::: "memory");
        }
        asm volatile("s_waitcnt vmcnt(0)" ::: "memory");
#undef GLOAD16
    }
}

DEVI void phase_scan(const Params& P, int l, LAS unsigned char* lds, int wv) {
    int tid_l = wv * 64 + (int)__lane_id(); asm volatile("" : "+v"(tid_l));
    unsigned char* ws = launder_ws(P.ws); asm volatile("" : "+s"(l));
    const int lane = tid_l & 63, wave = __builtin_amdgcn_readfirstlane(tid_l >> 6);
    constexpr int NS = 16, NSET = 2048 / NS, VEC = 6 * 64;
    LAS float* ring = (LAS float*)lds;
    const u16* PR = (const u16*)(ws + OFF_PR);
    const int dir = wave >> 2, rq = wave & 3, jrow = lane & 15;
    for (int bh = blockIdx.x; bh < 256; bh += gridDim.x) {
        const int b = bh >> 3, h = bh & 7, col = h * 64 + lane;
        const u16* prow = PR + (size_t)b * T_ * 2048 + h * 64;
        const float* mup = P.in[I_MUP] + l * 1952; const float* mun = P.in[I_MUN] + l * 1952;
        const float mpr = mup[col], mnr = mun[col], mpk = mup[512 + col], mnk = mun[512 + col], mpv = mup[1024 + col], mnv = mun[1024 + col];
        const float kkw = P.in[I_KK][l * 512 + col], kaw = P.in[I_KA][l * 512 + col];
        const u16* Ep = (const u16*)(ws + (dir ? OFF_EB : OFF_EF)) + (size_t)b * T_ * 512 + h * 64;
        const u16* Ap = (const u16*)(ws + (dir ? OFF_AB : OFF_AF)) + (size_t)b * T_ * 512 + h * 64;
        u16* Yp = (u16*)(ws + (dir ? OFF_YB : OFF_YF)) + (size_t)b * T_ * 512 + h * 64 + 16 * rq + 2 * (lane >> 3);
        f32x2 S2[2][4];
#pragma unroll
        for (int i = 0; i < 2; ++i)
#pragma unroll
            for (int c = 0; c < 4; ++c) S2[i][c] = (f32x2){0.f, 0.f};
        const float mAr = dir ? mnr : mpr, mBr = dir ? mpr : mnr, mAk = dir ? mnk : mpk, mBk = dir ? mpk : mnk, mAv = dir ? mnv : mpv, mBv = dir ? mpv : mnv;
        unsigned rwr[6][3], rwe[4], rwa[4];
#define SCAN_ISSUE(set_) do { const int s0_ = (set_) * NS + 4 * rq; \
            _Pragma("unroll") for (int ix = 0; ix < 6; ++ix) { int pos = s0_ - 1 + ix; pos = pos < 0 ? 0 : (pos > 2047 ? 2047 : pos); const int tm = dir ? 2047 - pos : pos; \
                const u16* pc = prow + (size_t)tm * 2048; rwr[ix][0] = pc[lane]; rwr[ix][1] = pc[512 + lane]; rwr[ix][2] = pc[1024 + lane]; } \
            _Pragma("unroll") for (int q = 0; q < 4; ++q) { const int pos = s0_ + q; const int tm = dir ? 2047 - pos : pos; \
                rwe[q] = Ep[(size_t)tm * 512 + lane]; rwa[q] = Ap[(size_t)tm * 512 + lane]; } } while (0)
#define SCAN_PRODUCE(set_) do { const int s0_ = (set_) * NS + 4 * rq; \
            _Pragma("unroll") for (int q = 0; q < 4; ++q) { \
            const int st = 4 * rq + q, pos = s0_ + q; \
            const float fA = pos > 0 ? 1.f : 0.f, fB = pos < 2047 ? 1.f : 0.f; \
            const float c0 = bf2f(rwr[q + 1][0]), c1 = bf2f(rwr[q + 1][1]), c2 = bf2f(rwr[q + 1][2]); \
            const float r_ = c0 + mAr * (fA * bf2f(rwr[q][0]) - c0) + mBr * (fB * bf2f(rwr[q + 2][0]) - c0); \
            const float k_ = c1 + mAk * (fA * bf2f(rwr[q][1]) - c1) + mBk * (fB * bf2f(rwr[q + 2][1]) - c1); \
            const float v_ = c2 + mAv * (fA * bf2f(rwr[q][2]) - c2) + mBv * (fB * bf2f(rwr[q + 2][2]) - c2); \
            const float kkv = k_ * kkw; const float ss = wave_sum_dpp(kkv * kkv); \
            const float kkn = kkv * __builtin_amdgcn_rsqf(fmaxf(ss, 1e-24f)); \
            const float a_ = bf2f(rwa[q]), w_ = __builtin_amdgcn_exp2f(bf2f(rwe[q]) * (-0.60653065971f * 1.44269504089f)); \
            LAS float* o = ring + ((((set_) & 1) * 2 + dir) * NS + st) * VEC + lane; \
            o[0] = -kkn; o[64] = w_; o[128] = kkn * a_; o[192] = k_ * (1.f + (a_ - 1.f) * kaw); o[256] = r_; o[320] = v_; } } while (0)
        SCAN_ISSUE(0);
        SCAN_PRODUCE(0);
        SCAN_ISSUE(1);
        __syncthreads();
        for (int set = 0; set < NSET; ++set) {
            if (set + 1 < NSET) SCAN_PRODUCE(set + 1);
            if (set + 2 < NSET) SCAN_ISSUE(set + 2);
            const LAS float* sb = ring + ((set & 1) * 2 + dir) * NS * VEC + 8 * (lane & 7);
            const int voff = 320 + 16 * rq + 2 * (lane >> 3) - 8 * (lane & 7);
#pragma unroll 2
            for (int st = 0; st < NS; ++st) {
                const LAS float* sm = sb + st * VEC;
                const f32x2 vv = *(const LAS f32x2*)(sm + voff);
                const f32x4 z0 = *(const LAS f32x4*)(sm), z1 = *(const LAS f32x4*)(sm + 4), w0 = *(const LAS f32x4*)(sm + 64), w1 = *(const LAS f32x4*)(sm + 68),
                            b0 = *(const LAS f32x4*)(sm + 128), b1 = *(const LAS f32x4*)(sm + 132), d0 = *(const LAS f32x4*)(sm + 192), d1 = *(const LAS f32x4*)(sm + 196),
                            r0 = *(const LAS f32x4*)(sm + 256), r1 = *(const LAS f32x4*)(sm + 260);
                const f32x2 zp[4] = {(f32x2){z0.x, z0.y}, (f32x2){z0.z, z0.w}, (f32x2){z1.x, z1.y}, (f32x2){z1.z, z1.w}};
                const f32x2 wp[4] = {(f32x2){w0.x, w0.y}, (f32x2){w0.z, w0.w}, (f32x2){w1.x, w1.y}, (f32x2){w1.z, w1.w}};
                const f32x2 bp[4] = {(f32x2){b0.x, b0.y}, (f32x2){b0.z, b0.w}, (f32x2){b1.x, b1.y}, (f32x2){b1.z, b1.w}};
                const f32x2 dp[4] = {(f32x2){d0.x, d0.y}, (f32x2){d0.z, d0.w}, (f32x2){d1.x, d1.y}, (f32x2){d1.z, d1.w}};
                const f32x2 rp[4] = {(f32x2){r0.x, r0.y}, (f32x2){r0.z, r0.w}, (f32x2){r1.x, r1.y}, (f32x2){r1.z, r1.w}};
                f32x2 sA = S2[0][0] * zp[0] + S2[0][1] * zp[1], sB = S2[0][2] * zp[2] + S2[0][3] * zp[3];
                f32x2 sC = S2[1][0] * zp[0] + S2[1][1] * zp[1], sD = S2[1][2] * zp[2] + S2[1][3] * zp[3];
                const f32x2 s0v = sA + sB, s1v = sC + sD;
                float sz0 = s0v.x + s0v.y, sz1 = s1v.x + s1v.y; red8x2(sz0, sz1);
                const f32x2 z0v = (f32x2){sz0, sz0}, z1v = (f32x2){sz1, sz1}, vxv = (f32x2){vv.x, vv.x}, vyv = (f32x2){vv.y, vv.y};
                f32x2 yA = (f32x2){0.f, 0.f}, yB = yA;
#pragma unroll
                for (int c = 0; c < 4; ++c) {
                    S2[0][c] = S2[0][c] * wp[c] + z0v * bp[c] + vxv * dp[c]; yA += S2[0][c] * rp[c];
                    S2[1][c] = S2[1][c] * wp[c] + z1v * bp[c] + vyv * dp[c]; yB += S2[1][c] * rp[c];
                }
                const float ya0 = yA.x, yb0 = yA.y, ya1 = yB.x, yb1 = yB.y;
                float y0 = ya0 + yb0, y1 = ya1 + yb1; red8x2(y0, y1);
                const int s_ = set * NS + st, tm = dir ? 2047 - s_ : s_;
                if ((lane & 7) == 0) *(unsigned*)(Yp + (size_t)tm * 512) = pk2(y0, y1);
            }
            LDS_WAIT(); __builtin_amdgcn_s_barrier();
        }
#undef SCAN_ISSUE
#undef SCAN_PRODUCE
    }
}

DEVI void phase_rwkv_post(const Params& P, int l, int wv) {
    int tid_l = wv * 64 + (int)__lane_id(); asm volatile("" : "+v"(tid_l));
    unsigned char* ws = launder_ws(P.ws); asm volatile("" : "+s"(l));
    const int lane = tid_l & 63, wave = tid_l >> 6;
    const int gw = blockIdx.x * 8 + wave, NGW = gridDim.x * 8;
    const int ch0 = lane * 8;
    const u16* PR = (const u16*)(ws + OFF_PR); const u16* AF = (const u16*)(ws + OFF_AF); const u16* AB = (const u16*)(ws + OFF_AB);
    const u16* G = (const u16*)(ws + OFF_G); const u16* YF = (const u16*)(ws + OFF_YF); const u16* YB = (const u16*)(ws + OFF_YB);
    u16* YM = (u16*)(ws + OFF_A);
    float mp[3][8], mn[3][8], ka[8], gw_[8], gb_[8], rk[8];
#pragma unroll
    for (int i = 0; i < 3; ++i) { load8f(P.in[I_MUP] + l * 1952 + i * 512 + ch0, mp[i]); load8f(P.in[I_MUN] + l * 1952 + i * 512 + ch0, mn[i]); }
    load8f(P.in[I_KA] + l * 512 + ch0, ka); load8f(P.in[I_GNW] + l * 512 + ch0, gw_); load8f(P.in[I_GNB] + l * 512 + ch0, gb_); load8f(P.in[I_RK] + l * 512 + ch0, rk);
    u32x4 cu[14], nx[14];
#define RP_LOAD(D_, tok_) do { const int t_ = (tok_) & 2047; const u16* q_ = PR + (size_t)(tok_) * 2048 + ch0; \
        _Pragma("unroll") for (int i = 0; i < 3; ++i) { D_[3 * i] = *(const u32x4*)(q_ + i * 512); D_[3 * i + 1] = *(const u32x4*)(q_ + i * 512 - (t_ > 0 ? 2048 : 0)); D_[3 * i + 2] = *(const u32x4*)(q_ + i * 512 + (t_ < T_ - 1 ? 2048 : 0)); } \
        D_[9] = __builtin_nontemporal_load((const u32x4*)(AF + (size_t)(tok_) * 512 + ch0)); D_[10] = __builtin_nontemporal_load((const u32x4*)(AB + (size_t)(tok_) * 512 + ch0)); D_[11] = __builtin_nontemporal_load((const u32x4*)(G + (size_t)(tok_) * 512 + ch0)); \
        D_[12] = __builtin_nontemporal_load((const u32x4*)(YF + (size_t)(tok_) * 512 + ch0)); D_[13] = __builtin_nontemporal_load((const u32x4*)(YB + (size_t)(tok_) * 512 + ch0)); } while (0)
    if (gw < MTOK) RP_LOAD(cu, gw);
    for (int tok = gw; tok < MTOK; tok += NGW) {
        const int t = tok & 2047;
        const int tn = tok + NGW < MTOK ? tok + NGW : tok;
        RP_LOAD(nx, tn);
        const float fp = t > 0 ? 1.f : 0.f, fn = t < T_ - 1 ? 1.f : 0.f;
        float x[3][8];
#pragma unroll
        for (int i = 0; i < 3; ++i) { float pc[8], pp[8], pn[8]; unpack8(cu[3 * i], pc); unpack8(cu[3 * i + 1], pp); unpack8(cu[3 * i + 2], pn);
#pragma unroll
            for (int j = 0; j < 8; ++j) x[i][j] = pc[j] + mp[i][j] * (fp * pp[j] - pc[j]) + mn[i][j] * (fn * pn[j] - pc[j]); }
        float af[8], ab[8], g[8], yf[8], yb[8], y[8];
        unpack8(cu[9], af); unpack8(cu[10], ab); unpack8(cu[11], g); unpack8(cu[12], yf); unpack8(cu[13], yb);
        float s = 0.f;
#pragma unroll
        for (int j = 0; j < 8; ++j) { y[j] = yf[j] + yb[j]; s += y[j]; }
        const float mean = red8(s) * (1.f / 64.f); float s2 = 0.f, bs = 0.f;
#pragma unroll
        for (int j = 0; j < 8; ++j) { y[j] -= mean; s2 += y[j] * y[j];
            const float ks = x[1][j] * (2.f + (af[j] + ab[j] - 2.f) * ka[j]); bs += x[0][j] * ks * rk[j]; }
        const float rstd = __builtin_amdgcn_rsqf(red8(s2) * (1.f / 64.f) + GN_EPS_);
        bs = red8(bs);
        float o[8];
#pragma unroll
        for (int j = 0; j < 8; ++j) o[j] = (y[j] * rstd * gw_[j] + gb_[j] + bs * x[2][j]) * g[j];
        *(u32x4*)(YM + (size_t)tok * 1024 + ch0) = pack8(o);
#pragma unroll
        for (int i = 0; i < 14; ++i) cu[i] = nx[i];
    }
#undef RP_LOAD
}

DEVI void phase_act(const Params& P, int l, size_t dst_off, int wrap_mask, int wv) {
    int tid_l = wv * 64 + (int)__lane_id(); asm volatile("" : "+v"(tid_l));
    unsigned char* ws = launder_ws(P.ws); asm volatile("" : "+s"(l));
    const int gtid = blockIdx.x * 512 + tid_l, NT = gridDim.x * 512;
    u16* UA = (u16*)(ws + OFF_UA); const u16* UG = (const u16*)(ws + OFF_UG); u16* UD = (u16*)(ws + dst_off);
    for (int idx = gtid; idx < 8192 * 352; idx += NT) {
        const int chunk = idx / 352, cg8 = (idx % 352) * 8, tok0 = chunk * 8, t0 = tok0 & 2047;
        float w0[8], w1[8], w2[8], bs[8];
        load8f(P.in[I_FCW] + ((size_t)l * 3 + 0) * 2816 + cg8, w0); load8f(P.in[I_FCW] + ((size_t)l * 3 + 1) * 2816 + cg8, w1);
        load8f(P.in[I_FCW] + ((size_t)l * 3 + 2) * 2816 + cg8, w2); load8f(P.in[I_FCB] + (size_t)l * 2816 + cg8, bs);
        const u16* ug = UG + (size_t)tok0 * 2816 + cg8; const u16* ua = UA + (size_t)tok0 * 2816 + cg8;
        u32x4 gr[10], ar[8];
        const bool hp = t0 > 0, hn = (t0 + 8) < T_;
        gr[0] = *(const u32x4*)(hp ? ug - 2816 : ug);
#pragma unroll
        for (int i = 0; i < 8; ++i) { gr[i + 1] = *(const u32x4*)(ug + (size_t)i * 2816); ar[i] = __builtin_nontemporal_load((const u32x4*)(ua + (size_t)i * 2816)); }
        gr[9] = *(const u32x4*)(hn ? ug + (size_t)8 * 2816 : ug);
        if (!hp) gr[0] = (u32x4){0u, 0u, 0u, 0u};
        if (!hn) gr[9] = (u32x4){0u, 0u, 0u, 0u};
        float prev[8], cur[8], nxt[8];
        unpack8(gr[0], prev); unpack8(gr[1], cur);
#pragma unroll
        for (int i = 0; i < 8; ++i) {
            unpack8(gr[i + 2], nxt);
            float a[8], o[8]; unpack8(ar[i], a);
#pragma unroll
            for (int j = 0; j < 8; j += 2) {
                f32x2 u = (f32x2){w0[j] * prev[j] + w1[j] * cur[j] + w2[j] * nxt[j] + bs[j], w0[j + 1] * prev[j + 1] + w1[j + 1] * cur[j + 1] + w2[j + 1] * nxt[j + 1] + bs[j + 1]};
                const f32x2 gl = pg8::gelu_pk(u); o[j] = gl.x * a[j]; o[j + 1] = gl.y * a[j + 1]; }
            *(u32x4*)(UD + (size_t)((tok0 + i) & wrap_mask) * 2816 + cg8) = pack8(o);
#pragma unroll
            for (int j = 0; j < 8; ++j) { prev[j] = cur[j]; cur[j] = nxt[j]; }
        }
    }
}

#define LAUNDER_WS() unsigned char* ws = launder_ws(P.ws); asm volatile("" : "+s"(l)); float* MOD = (float*)(ws + OFF_MOD); u16* HA = (u16*)(ws + OFF_A); const float* modl = MOD + (size_t)l * 32 * 6144; (void)modl; (void)HA
#ifndef DUP
#define DUP 0
#endif
#define REP(mask_) for (int rep_ = 0; rep_ < ((DUP & (mask_)) ? 2 : 1); ++rep_)
__global__ void __launch_bounds__(512, 2) mega_fwd(Params P) {
    extern __shared__ __attribute__((aligned(16))) unsigned char smem_[];
    LAS unsigned char* lds = (LAS unsigned char*)smem_;
    cg::grid_group grid = cg::this_grid();
    const int wv = __builtin_amdgcn_readfirstlane((int)threadIdx.x >> 6);
    volatile LAS unsigned* xst = (volatile LAS unsigned*)(lds + 131072);
    if (wv == 0 && __lane_id() == 0) { xst[0] = 0u; xst[1] = 0u; xst[2] = 0u; xst[3] = 0u; }
    __syncthreads();
    if (wv == 0 && __lane_id() == 0) (void)xb_add(&((unsigned*)P.ws)[XB_XCNT(xb_xcc_id())], 1u);
#define GSYNC() do { XcdBarrier b_; b_.bar = (unsigned*)launder_ws(P.ws); b_.x = xb_xcc_id(); b_.st = (volatile LAS unsigned*)(lds + 131072); xcd_barrier(b_, wv == 0 && __lane_id() == 0); } while (0)
    REP(16) phase_prologue(P, lds, wv);
    grid.sync();
    if (DUP & 32) { for (int i = 0; i < 20; ++i) GSYNC(); }
    REP(16) { int l = 0; LAUNDER_WS(); phase_ln<0>(P.in[I_X], nullptr, nullptr, nullptr, nullptr, nullptr, MOD + 0 * 1024, MOD + 1 * 1024, HA, wv); }
    GSYNC();
#pragma nounroll
    for (int l = 0; l < 2; ++l) {
        REP(1) { LAUNDER_WS(); EpiSplitBf16 E; E.O0 = (u16*)(ws + OFF_PR); E.O1 = (u16*)(ws + OFF_PH); E.nsplit = 8; E.ld0 = 2048; E.ld1 = 1536;
          run_gemm(lds, HA, (const u16*)(ws + OFF_WINT) + (size_t)l * 3584 * 1024, 3584, 1024, E, wv); }
        GSYNC();
        REP(4) phase_hy_prep(P, l, lds, wv);
        GSYNC();
        REP(4 | 64) phase_hy_conv(P, l, wv);
        GSYNC();
        REP(4) phase_hy_post(P, lds, wv);
        GSYNC();
        REP(8 | 128) phase_rwkv_prep(P, l, wv);
        GSYNC();
        REP(2) phase_scan(P, l, lds, wv);
        GSYNC();
        REP(8) phase_rwkv_post(P, l, wv);
        GSYNC();
        { LAUNDER_WS(); EpiSplitBf16 E; E.O0 = (u16*)(ws + OFF_B); E.O1 = E.O0; E.nsplit = 4; E.ld0 = 1024; E.ld1 = 1024;
          run_gemm(lds, HA, (const u16*)(ws + OFF_WOT) + (size_t)l * 1024 * 1024, 1024, 1024, E, wv); }
        GSYNC();
        { LAUNDER_WS(); phase_ln<1>((l == 0) ? P.in[I_X] : P.out, (const u16*)(ws + OFF_B), modl + 2 * 1024, P.out, P.in[I_LMG] + l * 1024, P.in[I_LMB] + l * 1024, modl + 3 * 1024, modl + 4 * 1024, HA, wv); }
        GSYNC();
        REP(1) { LAUNDER_WS(); EpiSplitBf16 E; E.O0 = (u16*)(ws + OFF_UA); E.O1 = (u16*)(ws + OFF_UG); E.nsplit = 11; E.ld0 = 2816; E.ld1 = 2816;
          run_gemm(lds, HA, (const u16*)(ws + OFF_WUT) + (size_t)l * 5632 * 1024, 5632, 1024, E, wv); }
        GSYNC();
        if (DUP & 512) phase_act(P, l, OFF_B + 704 * MiB, 16383, wv);
        phase_act(P, l, OFF_UA, 0x7fffffff, wv);
        GSYNC();
        { LAUNDER_WS(); EpiSplitBf16 E; E.O0 = HA; E.O1 = HA; E.nsplit = 4; E.ld0 = 1024; E.ld1 = 1024;
          run_gemm(lds, (const u16*)(ws + OFF_UA), (const u16*)(ws + OFF_WDT) + (size_t)l * 1024 * 2816, 1024, 2816, E, wv); }
        GSYNC();
        { LAUNDER_WS();
          if (l == 0) phase_ln<1>(P.out, HA, modl + 5 * 1024, P.out, P.in[I_LFG], P.in[I_LFB], MOD + (size_t)32 * 6144 + 0 * 1024, MOD + (size_t)32 * 6144 + 1 * 1024, HA, wv);
          else phase_ln<2>(P.out, HA, modl + 5 * 1024, P.out, P.in[I_LFG] + 1024, P.in[I_LFB] + 1024, nullptr, nullptr, nullptr, wv); }
        if (l == 0) GSYNC();
    }
#undef GSYNC
}

extern "C" void kernel_launch(void* const* d_in, const int* in_sizes, int n_in, void* d_out, int out_size, void* d_ws, size_t ws_size, hipStream_t stream) {
    static int grid = 0;
    constexpr int LDS_BYTES = 131072 + 16;
    if (grid == 0) {
        if (n_in != 36 || out_size != MTOK * 1024 || ws_size < WS_NEED) { fprintf(stderr, "kernel_launch: unexpected shapes (n_in %d out %d ws %zu)\n", n_in, out_size, ws_size); grid = -1; return; }
        int dev = 0, cus = 0, per_cu = 0;
        hipGetDevice(&dev); hipDeviceGetAttribute(&cus, hipDeviceAttributeMultiprocessorCount, dev);
        hipFuncSetAttribute((const void*)mega_fwd, hipFuncAttributeMaxDynamicSharedMemorySize, LDS_BYTES);
        hipOccupancyMaxActiveBlocksPerMultiprocessor(&per_cu, (const void*)mega_fwd, 512, LDS_BYTES);
        if (per_cu < 1) { fprintf(stderr, "kernel_launch: occupancy query says %d blocks/CU\n", per_cu); per_cu = 1; }
        grid = cus;
        (void)hipGetLastError();
    }
    if (grid < 0) return;
    if (hipMemsetAsync(d_ws, 0, 16384, stream) != hipSuccess) { fprintf(stderr, "kernel_launch: memset of the barrier words failed\n"); return; }
    Params p{};
    for (int i = 0; i < 36; ++i) p.in[i] = (const float*)d_in[i];
    p.out = (float*)d_out; p.ws = (unsigned char*)d_ws;
    void* args[] = {&p};
    hipError_t e = hipLaunchCooperativeKernel((const void*)mega_fwd, dim3(grid), dim3(512), args, LDS_BYTES, stream);
    if (e != hipSuccess) fprintf(stderr, "cooperative launch failed: %s (grid %d)\n", hipGetErrorString(e), grid);
}
```

```cpp
#include <hip/hip_runtime.h>
#include <hip/hip_cooperative_groups.h>
#include <cstdio>
#include <cstdint>
namespace cg = cooperative_groups;
namespace pg8 {
#define PG8_LAS __attribute__((address_space(3)))
typedef unsigned short bf16_t;
typedef short bf16x8 __attribute__((ext_vector_type(8)));
typedef float f32x4 __attribute__((ext_vector_type(4)));
typedef unsigned u32x4 __attribute__((ext_vector_type(4)));
constexpr int BM = 256, BK = 64, HALF = 128, HTB = HALF * BK * 2  , STAGE_BYTES = 8 * HTB, NXCD = 8, WGM = 4;

__host__ __device__ __forceinline__ int lds_byte(int r, int c) { const int st = (r >> 4) * 2 + (c >> 5), rr = r & 15, cc = c & 31, ob = rr * 64 + cc * 2; return st * 1024 + (ob ^ (((ob >> 9) & 1) << 5)); }
__host__ __device__ __forceinline__ void stage_rc(int b, int& R, int& C) { const int st = b / 1024, sb = b % 1024, swz = sb ^ (((sb >> 9) & 1) << 5); R = (st >> 1) * 16 + swz / 64; C = (st & 1) * 32 + (swz % 64) / 2; }
__host__ __device__ __forceinline__ int perm32(int rho) { const int n = rho >> 4, i = rho & 15; return 8 * (i >> 2) + 4 * n + (i & 3); }

struct Unit { int pm, pn; };
struct Gemm { const bf16_t* A; const bf16_t* Bt; int M, N, K; };

struct StaticOrder {
    int nM, nN, nwg, G, c;
    __host__ __device__ void init(int M, int N, int G_, int c_) { nM = M / BM; nN = N / BM; nwg = nM * nN; G = G_; c = c_; }
    __host__ __device__ bool next(int i, Unit& u) const {
        const long L = (long)i * G + c; if (L >= nwg) return false;
        int wgid = (int)L; { const int q = nwg / NXCD, r = nwg % NXCD, xcd = wgid % NXCD, off = wgid / NXCD; wgid = (xcd < r ? xcd * (q + 1) : r * (q + 1) + (xcd - r) * q) + off; }
        const int nig = WGM * nN, gid = wgid / nig, fm = gid * WGM, gsz = (nM - fm) < WGM ? (nM - fm) : WGM;
        u.pm = fm + ((wgid % nig) % gsz); u.pn = (wgid % nig) / gsz; return true;
    }
    __device__ __forceinline__ void a_ready(const Unit&) const {}
    __device__ __forceinline__ void done(const Unit&) const {}
};
__device__ __forceinline__ unsigned cvt_pk_bf16(float lo, float hi) { unsigned r; asm volatile("v_cvt_pk_bf16_f32 %0, %1, %2" : "=v"(r) : "v"(lo), "v"(hi)); return r; }
typedef float f32x2 __attribute__((ext_vector_type(2)));
__device__ __forceinline__ f32x2 gelu_pk(f32x2 v) {
    const f32x2 av = __builtin_elementwise_abs(v), d = av * 0.2316418882f + 1.0f;
    f32x2 t; t.x = __builtin_amdgcn_rcpf(d.x); t.y = __builtin_amdgcn_rcpf(d.y);
    f32x2 q = t * 0.5307027145f + (-0.7265760135f); q = q * t + 0.7107068705f; q = q * t + (-0.142248368f); q = q * t + 0.127414796f; q = q * t;
    const f32x2 s = (v * v) * (-0.72134752044f);
    f32x2 e; e.x = __builtin_amdgcn_exp2f(s.x); e.y = __builtin_amdgcn_exp2f(s.y);
    const f32x2 m = v * (q * e), r = v - m;
    f32x2 o; o.x = v.x < 0.f ? m.x : r.x; o.y = v.y < 0.f ? m.y : r.y; return o;
}
template <class Epi, class Sched, bool STAMP = false>
__device__ __forceinline__ void gemm_phase(PG8_LAS unsigned char* lds, const Gemm g, const Sched& S, const Epi& E, unsigned long long* stamps, const int wv) {
    int tid = wv * 64 + (int)__lane_id(); asm volatile("" : "+v"(tid)); const int wid = __builtin_amdgcn_readfirstlane(tid >> 6), lane = tid & 63, wr = wid >> 2, wc = wid & 3, fr = lane & 15, fq = lane >> 4;
    const int K = g.K, nt = K / BK;
    int ts_lo = 0, ts_hi = 0, nts = 0; const unsigned long long rt_entry = STAMP ? (unsigned long long)wall_clock64() : 0ull;
#define PG8_STAMP() do { if (STAMP && wid == 0 && nts < 64) { const unsigned long long _c = (unsigned long long)clock64(); \
        ts_lo = (lane == nts) ? (int)(unsigned)_c : ts_lo; ts_hi = (lane == nts) ? (int)(unsigned)(_c >> 32) : ts_hi; ++nts; } } while (0)
    PG8_STAMP();
    unsigned voffA[2], voffB[2];
#pragma unroll
    for (int i = 0; i < 2; ++i) { int R, C; stage_rc(tid * 16 + i * 8192, R, C); const int Rb = Epi::PERM ? ((R & ~31) + perm32(R & 31)) : R;
        voffA[i] = (unsigned)(R * K + C) * 2u; voffB[i] = (unsigned)(Rb * K + C) * 2u; }
    const size_t kstep = (size_t)(BK * 2);
    const size_t hstep = (size_t)HALF * K * 2;
    const size_t tstep = 2 * hstep;
    const unsigned ldsw = (unsigned)wid * 1024u;
    const int aoff = lds_byte(wr * 64 + fr, fq * 8), boff = lds_byte(wc * 32 + fr, fq * 8);
#define PG8_SA(b, h) (((b) * 2 + (h)) * HTB)
#define PG8_SB(b, h) ((4 + (b) * 2 + (h)) * HTB)
#define PG8_STAGE(bufoff, gbase, voff) do { _Pragma("unroll") for (int _i = 0; _i < 2; ++_i) \
        __builtin_amdgcn_global_load_lds((const unsigned*)((const char*)(gbase) + (voff)[_i]), (PG8_LAS unsigned*)(lds + (bufoff) + ldsw + _i * 8192), 16, 0, 0); } while (0)
#define PG8_LDA(dst, b, h) do { _Pragma("unroll") for (int m = 0; m < 4; ++m) _Pragma("unroll") for (int k = 0; k < 2; ++k) dst[m][k] = *(const PG8_LAS bf16x8*)(lds + PG8_SA(b, h) + aoff + m * 2048 + k * 1024); } while (0)
#define PG8_LDB(dst, b, h) do { _Pragma("unroll") for (int n = 0; n < 2; ++n) _Pragma("unroll") for (int k = 0; k < 2; ++k) dst[n][k] = *(const PG8_LAS bf16x8*)(lds + PG8_SB(b, h) + boff + n * 2048 + k * 1024); } while (0)
#define PG8_MMA(ai, bj, At, Bt) do { __builtin_amdgcn_s_setprio(1); _Pragma("unroll") for (int m = 0; m < 4; ++m) _Pragma("unroll") for (int n = 0; n < 2; ++n) _Pragma("unroll") for (int k = 0; k < 2; ++k) \
        acc[ai][bj][m][n] = __builtin_amdgcn_mfma_f32_16x16x32_bf16(Bt[n][k], At[m][k], acc[ai][bj][m][n], 0, 0, 0); __builtin_amdgcn_s_setprio(0); } while (0)
#define PG8_WAIT_V(n) asm volatile("s_waitcnt vmcnt(" #n ")" ::: "memory")
#define PG8_WAIT_L(n) asm volatile("s_waitcnt lgkmcnt(" #n ")" ::: "memory")
#define PG8_BAR __builtin_amdgcn_s_barrier()
#define PG8_SCHED __builtin_amdgcn_sched_barrier(0)
    Unit cur, nxt; int ui = 0;
    if (!S.next(0, cur)) return;
    f32x4 acc[2][2][4][2];
#pragma unroll
    for (int a = 0; a < 2; ++a)
#pragma unroll
        for (int b = 0; b < 2; ++b)
#pragma unroll
            for (int m = 0; m < 4; ++m)
#pragma unroll
                for (int n = 0; n < 2; ++n) acc[a][b][m][n] = (f32x4){0.f, 0.f, 0.f, 0.f};
    bf16x8 At[4][2], B0[2][2], B1[2][2];
    const char* cA = (const char*)g.A + (size_t)cur.pm * tstep; const char* cB = (const char*)g.Bt + (size_t)cur.pn * tstep;
    S.a_ready(cur);
    PG8_STAGE(PG8_SB(0, 0), cB, voffB); PG8_STAGE(PG8_SA(0, 0), cA, voffA); PG8_STAGE(PG8_SB(0, 1), cB + hstep, voffB); PG8_STAGE(PG8_SA(0, 1), cA + hstep, voffA);
    if (wr == 1) PG8_BAR;
    PG8_WAIT_V(4); PG8_BAR;
    PG8_STAGE(PG8_SB(1, 0), cB + kstep, voffB); PG8_STAGE(PG8_SA(1, 0), cA + kstep, voffA); PG8_STAGE(PG8_SB(1, 1), cB + hstep + kstep, voffB);
    PG8_WAIT_V(6); PG8_BAR;
    PG8_STAMP();
    for (;;) {
        const bool has_next = S.next(ui + 1, nxt);
        const char* nA = has_next ? (const char*)g.A + (size_t)nxt.pm * tstep : cA; const char* nB = has_next ? (const char*)g.Bt + (size_t)nxt.pn * tstep : cB;
        for (int t = 0; t < nt; t += 2) {
            const bool last = (t == nt - 2);
            const char* a1 = cA + (size_t)(t + 1) * kstep;
            const char* a2 = last ? nA : cA + (size_t)(t + 2) * kstep; const char* b2 = last ? nB : cB + (size_t)(t + 2) * kstep;
            const char* a3 = a2 + kstep; const char* b3 = b2 + kstep;
            if (last && has_next) S.a_ready(nxt);
            PG8_LDB(B0, 0, 0); PG8_SCHED; PG8_LDA(At, 0, 0); PG8_STAGE(PG8_SA(1, 1), a1 + hstep, voffA);
            PG8_WAIT_L(8); PG8_BAR; PG8_WAIT_L(0); PG8_MMA(0, 0, At, B0); PG8_BAR; PG8_SCHED;
            PG8_LDB(B1, 0, 1); PG8_STAGE(PG8_SB(0, 0), b2, voffB);
            PG8_BAR; PG8_WAIT_L(0); PG8_MMA(0, 1, At, B1); PG8_BAR;
            PG8_LDA(At, 0, 1); PG8_STAGE(PG8_SA(0, 0), a2, voffA);
            PG8_BAR; PG8_WAIT_L(0); PG8_MMA(1, 0, At, B0); PG8_BAR; PG8_SCHED;
            PG8_STAGE(PG8_SB(0, 1), b2 + hstep, voffB);
            PG8_WAIT_V(6); PG8_BAR; PG8_MMA(1, 1, At, B1); PG8_BAR;
            PG8_LDB(B0, 1, 0); PG8_SCHED; PG8_LDA(At, 1, 0); PG8_STAGE(PG8_SA(0, 1), a2 + hstep, voffA);
            PG8_WAIT_L(8); PG8_BAR; PG8_WAIT_L(0); PG8_MMA(0, 0, At, B0); PG8_BAR; PG8_SCHED;
            PG8_LDB(B1, 1, 1); PG8_STAGE(PG8_SB(1, 0), b3, voffB);
            PG8_BAR; PG8_WAIT_L(0); PG8_MMA(0, 1, At, B1); PG8_BAR;
            PG8_LDA(At, 1, 1); PG8_STAGE(PG8_SA(1, 0), a3, voffA);
            PG8_BAR; PG8_WAIT_L(0); PG8_MMA(1, 0, At, B0); PG8_BAR; PG8_SCHED;
            PG8_STAGE(PG8_SB(1, 1), b3 + hstep, voffB);
            PG8_WAIT_V(6); PG8_BAR; PG8_MMA(1, 1, At, B1); PG8_BAR;
        }
        PG8_STAMP();
        if constexpr (!Epi::AFTER_DRAIN) { E(acc, cur, wr, wc, fr, fq); S.done(cur); }
        PG8_STAMP();
        if (!has_next) break;
#pragma unroll
        for (int a = 0; a < 2; ++a)
#pragma unroll
            for (int b = 0; b < 2; ++b)
#pragma unroll
                for (int m = 0; m < 4; ++m)
#pragma unroll
                    for (int n = 0; n < 2; ++n) acc[a][b][m][n] = (f32x4){0.f, 0.f, 0.f, 0.f};
        cur = nxt; cA = nA; cB = nB; ++ui;
    }
    PG8_WAIT_V(0);
    if (wr == 0) PG8_BAR;
    PG8_BAR;
    if constexpr (Epi::AFTER_DRAIN) { E.fused(acc, cur, wr, wc, fr, fq, lds, wid, lane); S.done(cur); }
    PG8_STAMP();
    if (STAMP && wid == 0) { stamps[lane] = lane < nts ? (((unsigned long long)(unsigned)ts_hi << 32) | (unsigned)ts_lo) : 0ull;
        if (lane == 62) stamps[62] = rt_entry; if (lane == 63) stamps[63] = (unsigned long long)wall_clock64(); }
#undef PG8_STAMP
#undef PG8_SA
#undef PG8_SB
#undef PG8_STAGE
#undef PG8_LDA
#undef PG8_LDB
#undef PG8_MMA
#undef PG8_WAIT_V
#undef PG8_WAIT_L
#undef PG8_BAR
#undef PG8_SCHED
}
}

using pg8::bf16_t; using pg8::bf16x8; using pg8::f32x4; using pg8::u32x4; using pg8::Unit; using pg8::f32x2;
typedef unsigned short u16;
typedef float f32x16 __attribute__((ext_vector_type(16)));
typedef bf16x8 bf16x8_a4 __attribute__((aligned(4)));
typedef u32x4 u32x4_a4 __attribute__((aligned(4)));
typedef unsigned u32x2 __attribute__((ext_vector_type(2)));
#define DEVI __device__ __forceinline__
#define LAS __attribute__((address_space(3)))
#define LDS_WAIT() asm volatile("s_waitcnt lgkmcnt(0)" ::: "memory")
#define GAS __attribute__((address_space(1)))
DEVI unsigned char* launder_ws(unsigned char* p) { GAS unsigned char* g = (GAS unsigned char*)p; asm volatile("" : "+s"(g)); return (unsigned char*)g; }

#define XB_TMO      128
#define XB_XCNT(j)  (256  + 64 * (j))
#define XB_XSUB(j)  (1280 + 64 * (j))
#define XB_XGEN(j)  (2304 + 64 * (j))
#define XB_TOP      3328
#define XB_TOPGEN   3392
#define XCD_BAR_WORDS 3456
#define XB_SPIN_CAP (1u << 18)
__device__ __forceinline__ unsigned xb_ld(unsigned* p)              { return __hip_atomic_load(p, __ATOMIC_RELAXED, __HIP_MEMORY_SCOPE_AGENT); }
__device__ __forceinline__ unsigned xb_add(unsigned* p, unsigned v) { return __hip_atomic_fetch_add(p, v, __ATOMIC_RELAXED, __HIP_MEMORY_SCOPE_AGENT); }
__device__ __forceinline__ unsigned xb_xcc_id() { return (unsigned)__builtin_amdgcn_s_getreg((3 << 11) | 20) & 0xFu; }
#define XB_SPIN(cond, bar) do { unsigned _sp = 0; while (cond) { __builtin_amdgcn_s_sleep(1); \
    if ((++_sp & 255u) == 0u) { if (xb_ld(&(bar)[XB_TMO])) break; if (_sp > XB_SPIN_CAP) { atomicAdd(&(bar)[XB_TMO], 1u); break; } } } } while (0)

struct XcdBarrier {
    unsigned* bar; unsigned x;
    volatile LAS unsigned* st;
};

__device__ __forceinline__ XcdBarrier xcd_barrier_post(unsigned* bar, volatile LAS unsigned* st) {
    XcdBarrier b; b.bar = bar; b.x = xb_xcc_id(); b.st = st;
    if (threadIdx.x == 0) (void)xb_add(&bar[XB_XCNT(b.x)], 1u);
    return b;
}
__device__ __forceinline__ void xcd_barrier_complete(unsigned* bar, unsigned x, unsigned& nloc, unsigned& nx) {
    const unsigned G = gridDim.x * gridDim.y * gridDim.z;
    unsigned sum, cnt, mine, sp = 0u;
    for (;;) {
        sum = 0u; cnt = 0u; mine = 0u;
#pragma unroll
        for (unsigned j = 0; j < 16; ++j) { const unsigned c = xb_ld(&bar[XB_XCNT(j)]); sum += c; cnt += (c > 0u) ? 1u : 0u; mine = (j == x) ? c : mine; }
        if (sum == G) break;
        __builtin_amdgcn_s_sleep(1);
        if ((++sp & 255u) == 0u) { if (xb_ld(&bar[XB_TMO])) break; if (sp > XB_SPIN_CAP) { atomicAdd(&bar[XB_TMO], 1u); break; } }
    }
    nloc = mine > 0u ? mine : 1u; nx = cnt > 0u ? cnt : 1u;
}

__device__ __forceinline__ void xcd_barrier(const XcdBarrier& b, const bool leader) {
    asm volatile("s_waitcnt vmcnt(0)" ::: "memory");
    __syncthreads();
    if (leader) {
        unsigned* bar = b.bar;
        __builtin_amdgcn_s_waitcnt(0);
        unsigned nloc = b.st[0], nx = b.st[1];
        if (nloc == 0u) { xcd_barrier_complete(bar, b.x, nloc, nx); b.st[0] = nloc; b.st[1] = nx; }
        const unsigned old = xb_add(&bar[XB_XSUB(b.x)], 1u);
        const unsigned gen = old / nloc;
        if (old + 1u == (gen + 1u) * nloc) {
            __builtin_amdgcn_fence(__ATOMIC_RELEASE, "agent");
            asm volatile("s_waitcnt vmcnt(0)" ::: "memory");
            const unsigned og = xb_add(&bar[XB_TOP], 1u);
            const unsigned tg = og / nx;
            if (og + 1u == (tg + 1u) * nx) xb_add(&bar[XB_TOPGEN], 1u);
            else XB_SPIN(xb_ld(&bar[XB_TOPGEN]) == tg, bar);
            __builtin_amdgcn_fence(__ATOMIC_ACQUIRE, "agent");
            xb_add(&bar[XB_XGEN(b.x)], 1u);
            asm volatile("s_waitcnt vmcnt(0)" ::: "memory");
        } else {
            XB_SPIN(xb_ld(&bar[XB_XGEN(b.x)]) == gen, bar);
            __builtin_amdgcn_fence(__ATOMIC_ACQUIRE, "agent");
            asm volatile("s_waitcnt vmcnt(0)" ::: "memory");
        }
    }
    __syncthreads();
}

constexpr int T_ = 2048, MTOK = 65536;
constexpr float ALPHA_ = 1.41421356237f, LN_EPS_ = 1e-5f, GN_EPS_ = 64e-5f;
constexpr size_t MiB = 1u << 20;
constexpr size_t OFF_WINT = 1 * MiB, OFF_WOT = 15 * MiB, OFF_WUT = 19 * MiB, OFF_WDT = 41 * MiB, OFF_LT = 52 * MiB, OFF_MOD = 53 * MiB, OFF_GT = 55 * MiB,
                 OFF_A = 72 * MiB, OFF_B = 200 * MiB;
constexpr size_t OFF_PR = OFF_B, OFF_PH = OFF_B + 256 * MiB, OFF_UT = OFF_B + 448 * MiB, OFF_X0 = OFF_B + 512 * MiB, OFF_CONVT = OFF_B + 576 * MiB;
constexpr size_t OFF_EF = OFF_B + 256 * MiB, OFF_EB = OFF_B + 320 * MiB, OFF_AF = OFF_B + 384 * MiB, OFF_AB = OFF_B + 448 * MiB, OFF_G = OFF_B + 512 * MiB,
                 OFF_YF = OFF_B + 576 * MiB, OFF_YB = OFF_B + 640 * MiB;
constexpr size_t OFF_UA = OFF_B, OFF_UG = OFF_B + 352 * MiB;
constexpr size_t WS_NEED = OFF_B + 704 * MiB;
constexpr int GT_STRIDE = 4112;
constexpr int LT_PER_LAYER = 2 * 512 * 64 * 2 + 512 * 160;

struct Params { const float* in[36]; float* out; unsigned char* ws; };
enum { I_X = 0, I_C, I_WADA, I_BADA, I_ADAT, I_WIN, I_MUP, I_MUN, I_HCW, I_HCB, I_W0, I_WUP, I_A0, I_AUP, I_GUP, I_KK, I_KA, I_RK, I_GNW, I_GNB,
       I_FW1, I_FB1, I_FWIN, I_FBIN, I_FFREQ, I_FWOUT, I_HBIAS, I_WOUT, I_LMG, I_LMB, I_FUP, I_FCW, I_FCB, I_FDN, I_LFG, I_LFB };

DEVI u16 f2bf(float f) { unsigned u = __float_as_uint(f); u += 0x7FFFu + ((u >> 16) & 1u); return (u16)(u >> 16); }
DEVI float bf2f(unsigned b) { return __uint_as_float(b << 16); }
DEVI float bflo(unsigned w) { return __uint_as_float(w << 16); }
DEVI float bfhi(unsigned w) { return __uint_as_float(w & 0xFFFF0000u); }
DEVI unsigned pk2(float lo, float hi) { return pg8::cvt_pk_bf16(lo, hi); }
DEVI float wave_sum(float v) {
#pragma unroll
    for (int o = 1; o < 64; o <<= 1) v += __shfl_xor(v, o);
    return v;
}
DEVI float sum8(float v) { v += __shfl_xor(v, 1); v += __shfl_xor(v, 2); v += __shfl_xor(v, 4); return v; }
DEVI float sigmoidf_(float x) { return __builtin_amdgcn_rcpf(1.f + __expf(-x)); }
DEVI float tanhf_(float x) { return 1.f - 2.f * __builtin_amdgcn_rcpf(__expf(2.f * x) + 1.f); }
DEVI void unpack8(const u32x4 w, float (&o)[8]) { o[0] = bflo(w.x); o[1] = bfhi(w.x); o[2] = bflo(w.y); o[3] = bfhi(w.y); o[4] = bflo(w.z); o[5] = bfhi(w.z); o[6] = bflo(w.w); o[7] = bfhi(w.w); }
DEVI u32x4 pack8(const float (&v)[8]) { u32x4 w; w.x = pk2(v[0], v[1]); w.y = pk2(v[2], v[3]); w.z = pk2(v[4], v[5]); w.w = pk2(v[6], v[7]); return w; }
DEVI void load8f(const float* p, float (&o)[8]) { const f32x4 a = *(const f32x4*)p, b = *(const f32x4*)(p + 4); o[0] = a.x; o[1] = a.y; o[2] = a.z; o[3] = a.w; o[4] = b.x; o[5] = b.y; o[6] = b.z; o[7] = b.w; }

#define FMAC_DPP(acc_, d_, o_, N_) asm("v_fmac_f32_dpp %0, %1, %2 row_ror:" #N_ " row_mask:0xf bank_mask:0xf" : "+v"(acc_) : "v"(d_), "v"(o_))
#define MUL_DPP(dst_, d_, o_, N_) asm("v_mul_f32_dpp %0, %1, %2 row_ror:" #N_ " row_mask:0xf bank_mask:0xf" : "=v"(dst_) : "v"(d_), "v"(o_))
DEVI float red4(float x) {
    float a = x, b = x;
    asm volatile("s_nop 1\n\tv_permlane16_swap_b32 %0, %1" : "+v"(a), "+v"(b));
    const float s = a + b;
    a = s; b = s;
    asm volatile("s_nop 1\n\tv_permlane32_swap_b32 %0, %1" : "+v"(a), "+v"(b));
    return a + b;
}
DEVI float red8(float x) {
    float t;
    asm("s_nop 1\n\tv_add_f32_dpp %0, %1, %1 quad_perm:[1,0,3,2] row_mask:0xf bank_mask:0xf" : "=v"(t) : "v"(x)); x = t;
    asm("s_nop 1\n\tv_add_f32_dpp %0, %1, %1 quad_perm:[2,3,0,1] row_mask:0xf bank_mask:0xf" : "=v"(t) : "v"(x)); x = t;
    asm("s_nop 1\n\tv_add_f32_dpp %0, %1, %1 row_half_mirror row_mask:0xf bank_mask:0xf" : "=v"(t) : "v"(x));
    return t;
}
DEVI void red8x2(float& x0, float& x1) {
    asm volatile("s_nop 1\n\t"
                 "v_add_f32_dpp %0, %0, %0 quad_perm:[1,0,3,2] row_mask:0xf bank_mask:0xf\n\t"
                 "v_add_f32_dpp %1, %1, %1 quad_perm:[1,0,3,2] row_mask:0xf bank_mask:0xf\n\t"
                 "s_nop 0\n\t"
                 "v_add_f32_dpp %0, %0, %0 quad_perm:[2,3,0,1] row_mask:0xf bank_mask:0xf\n\t"
                 "v_add_f32_dpp %1, %1, %1 quad_perm:[2,3,0,1] row_mask:0xf bank_mask:0xf\n\t"
                 "s_nop 0\n\t"
                 "v_add_f32_dpp %0, %0, %0 row_half_mirror row_mask:0xf bank_mask:0xf\n\t"
                 "v_add_f32_dpp %1, %1, %1 row_half_mirror row_mask:0xf bank_mask:0xf"
                 : "+v"(x0), "+v"(x1));
}
DEVI float wave_sum_dpp(float x) {
    float t;
    asm("s_nop 1\n\tv_add_f32_dpp %0, %1, %1 row_ror:1 row_mask:0xf bank_mask:0xf" : "=v"(t) : "v"(x)); x = t;
    asm("s_nop 1\n\tv_add_f32_dpp %0, %1, %1 row_ror:2 row_mask:0xf bank_mask:0xf" : "=v"(t) : "v"(x)); x = t;
    asm("s_nop 1\n\tv_add_f32_dpp %0, %1, %1 row_ror:4 row_mask:0xf bank_mask:0xf" : "=v"(t) : "v"(x)); x = t;
    asm("s_nop 1\n\tv_add_f32_dpp %0, %1, %1 row_ror:8 row_mask:0xf bank_mask:0xf" : "=v"(t) : "v"(x)); x = t;
    return red4(x);
}

struct EpiSplitBf16 {
    static constexpr bool PERM = true, AFTER_DRAIN = false;
    u16* O0; u16* O1; int nsplit, ld0, ld1;
    __device__ __forceinline__ void operator()(const f32x4 (&acc)[2][2][4][2], const Unit& u, int wr, int wc, int fr, int fq) const {
        const int row0 = u.pm * 256 + wr * 64 + fr;
        u16* base; int ldc, colt;
        if (u.pn < nsplit) { base = O0; ldc = ld0; colt = u.pn * 256; } else { base = O1; ldc = ld1; colt = (u.pn - nsplit) * 256; }
        const int col0 = colt + wc * 32 + 8 * fq;
#pragma unroll
        for (int ai = 0; ai < 2; ++ai)
#pragma unroll
            for (int m = 0; m < 4; ++m) { u16* rowp = base + (size_t)(row0 + ai * 128 + m * 16) * ldc + col0;
#pragma unroll
                for (int bj = 0; bj < 2; ++bj) { const f32x4 v0 = acc[ai][bj][m][0], v1 = acc[ai][bj][m][1];
                    u32x4 w; w.x = pk2(v0[0], v0[1]); w.y = pk2(v0[2], v0[3]); w.z = pk2(v1[0], v1[1]); w.w = pk2(v1[2], v1[3]);
                    *(u32x4*)(rowp + bj * 128) = w; } }
    }
};
struct EpiRes {
    static constexpr bool PERM = false, AFTER_DRAIN = false;
    const float* xin; float* xout; const float* gate;
    __device__ __forceinline__ void operator()(const f32x4 (&acc)[2][2][4][2], const Unit& u, int wr, int wc, int fr, int fq) const {
        const int row0 = u.pm * 256 + wr * 64 + fr, col0 = u.pn * 256 + wc * 32 + 4 * fq;
        const float* gp = gate + (size_t)(u.pm >> 3) * 6144 + col0;
        f32x4 gv[2][2];
#pragma unroll
        for (int bj = 0; bj < 2; ++bj)
#pragma unroll
            for (int n = 0; n < 2; ++n) gv[bj][n] = *(const f32x4*)(gp + bj * 128 + n * 16) + 1.0f;
#pragma unroll
        for (int ai = 0; ai < 2; ++ai)
#pragma unroll
            for (int m = 0; m < 4; ++m) { const size_t off = (size_t)(row0 + ai * 128 + m * 16) * 1024 + col0;
#pragma unroll
                for (int bj = 0; bj < 2; ++bj)
#pragma unroll
                    for (int n = 0; n < 2; ++n) { const f32x4 xv = *(const f32x4*)(xin + off + bj * 128 + n * 16);
                        *(f32x4*)(xout + off + bj * 128 + n * 16) = xv * ALPHA_ + gv[bj][n] * acc[ai][bj][m][n]; } }
    }
};

template <class Epi> DEVI void run_gemm(LAS unsigned char* lds, const u16* A, const u16* Bt, int N, int K, const Epi& E, int wv) {
    pg8::Gemm g; g.A = A; g.Bt = Bt; g.M = MTOK; g.N = N; g.K = K;
    pg8::StaticOrder S; S.init(MTOK, N, (int)gridDim.x, (int)blockIdx.x);
    pg8::gemm_phase<Epi, pg8::StaticOrder, false>(lds, g, S, E, nullptr, wv);
}

DEVI void transpose_item(const float* W, int K, int N, u16* WT, int drow, LAS float* scr, int k0, int n0, int lane) {
#pragma unroll 8
    for (int i = 0; i < 32; ++i) { const int kk = 2 * i + (lane >> 5); scr[kk * 33 + (lane & 31)] = W[(size_t)(k0 + kk) * N + n0 + (lane & 31)]; }
    LDS_WAIT();
    const int c = lane & 7;
#pragma unroll
    for (int j = 0; j < 4; ++j) { const int n = (lane >> 3) + 8 * j; const LAS float* s = scr + (8 * c) * 33 + n;
        u32x4 o; o.x = pk2(s[0 * 33], s[1 * 33]); o.y = pk2(s[2 * 33], s[3 * 33]); o.z = pk2(s[4 * 33], s[5 * 33]); o.w = pk2(s[6 * 33], s[7 * 33]);
        *(u32x4*)(WT + (size_t)(drow + n) * K + k0 + 8 * c) = o; }
    LDS_WAIT();
}

DEVI void phase_prologue(const Params& P, LAS unsigned char* lds, int wv) {
    int tid_l = wv * 64 + (int)__lane_id(); asm volatile("" : "+v"(tid_l));
    const int tid = tid_l, lane = tid & 63, wave = tid >> 6;
    unsigned char* ws = launder_ws(P.ws);
    float* MOD = (float*)(ws + OFF_MOD);
#if defined(PROBE_VALU)
    {
        float a[16]; float z = (float)tid * 1e-3f;
#pragma unroll
        for (int i = 0; i < 16; ++i) a[i] = (float)(tid + i) * 1e-4f;
        for (int it = 0; it < PROBE_N; ++it) {
#if PROBE_VALU == 1
            FMAC_DPP(a[1], z, a[0], 1); FMAC_DPP(a[2], z, a[0], 2); FMAC_DPP(a[3], z, a[0], 3); FMAC_DPP(a[4], z, a[0], 4); FMAC_DPP(a[5], z, a[0], 5);
            FMAC_DPP(a[6], z, a[0], 6); FMAC_DPP(a[7], z, a[0], 7); FMAC_DPP(a[8], z, a[0], 8); FMAC_DPP(a[9], z, a[0], 9); FMAC_DPP(a[10], z, a[0], 10);
            FMAC_DPP(a[11], z, a[0], 11); FMAC_DPP(a[12], z, a[0], 12); FMAC_DPP(a[13], z, a[0], 13); FMAC_DPP(a[14], z, a[0], 14); FMAC_DPP(a[15], z, a[0], 15);
#else
#pragma unroll
            for (int i = 1; i < 16; ++i) asm volatile("v_fmac_f32_e32 %0, %1, %2" : "+v"(a[i]) : "v"(z), "v"(a[0]));
#endif
            asm volatile("" : "+v"(a[0]));
        }
        float sum = 0.f;
#pragma unroll
        for (int i = 0; i < 16; ++i) sum += a[i];
        if (sum == 123.456f) MOD[0] = sum;
    }
#endif
    {
        LAS float* red = (LAS float*)lds;
        const float* cin = P.in[I_C]; const float* W = P.in[I_WADA];
        const int r = lane & 31, hh = lane >> 5;
        for (int item = blockIdx.x; item < 192; item += gridDim.x) {
            const int n0 = item * 32;
            f32x16 acc;
#pragma unroll
            for (int i = 0; i < 16; ++i) acc[i] = 0.f;
#pragma unroll 16
            for (int ks = 0; ks < 64; ++ks) {
                const int k = wave * 128 + ks * 2 + hh;
                const float cv = cin[r * 1024 + k]; const float a = cv / (1.f + expf(-cv));
                const float bv = W[(size_t)k * 6144 + n0 + r];
                acc = __builtin_amdgcn_mfma_f32_32x32x2f32(a, bv, acc, 0, 0, 0);
            }
#pragma unroll
            for (int rg = 0; rg < 16; ++rg) { const int row = (rg & 3) + 8 * (rg >> 2) + 4 * hh; red[(wave * 32 + row) * 32 + r] = acc[rg]; }
            __syncthreads();
            for (int e = tid; e < 1024; e += 512) {
                const int row = e >> 5, col = e & 31; float s = 0.f;
#pragma unroll
                for (int w = 0; w < 8; ++w) s += red[(w * 32 + row) * 32 + col];
                const int n = n0 + col; s += P.in[I_BADA][n];
                const int gi = n >> 10, nn = n & 1023;
#pragma unroll
                for (int l = 0; l < 2; ++l) MOD[((size_t)(l * 32 + row) * 6 + gi) * 1024 + nn] = s + P.in[I_ADAT][(l * 6 + gi) * 1024 + nn];
            }
            __syncthreads();
        }
    }
    {
        LAS float* scr = (LAS float*)(lds + 32768) + wave * (64 * 33);
        const int gw = blockIdx.x * 8 + wave, NGW = gridDim.x * 8;
        u16* WINT = (u16*)(ws + OFF_WINT); u16* WOT = (u16*)(ws + OFF_WOT); u16* WUT = (u16*)(ws + OFF_WUT); u16* WDT = (u16*)(ws + OFF_WDT);
        for (int it = gw; it < 2 * 6480; it += NGW) {
            const int l = it / 6480; int r = it % 6480;
            if (r < 1744) { const int kb = r / 109, nb = r % 109, n0 = nb * 32, drow = n0 < 1952 ? n0 : n0 + 96;
                transpose_item(P.in[I_WIN] + (size_t)l * 1024 * 3488, 1024, 3488, WINT + (size_t)l * 3584 * 1024, drow, scr, kb * 64, n0, lane); continue; }
            r -= 1744;
            if (r < 512) { const int kb = r / 32, nb = r % 32;
                transpose_item(P.in[I_WOUT] + (size_t)l * 1024 * 1024, 1024, 1024, WOT + (size_t)l * 1024 * 1024, nb * 32, scr, kb * 64, nb * 32, lane); continue; }
            r -= 512;
            if (r < 2816) { const int kb = r / 176, nb = r % 176;
                transpose_item(P.in[I_FUP] + (size_t)l * 1024 * 5632, 1024, 5632, WUT + (size_t)l * 5632 * 1024, nb * 32, scr, kb * 64, nb * 32, lane); continue; }
            r -= 2816;
            { const int kb = r / 32, nb = r % 32;
                transpose_item(P.in[I_FDN] + (size_t)l * 2816 * 1024, 2816, 1024, WDT + (size_t)l * 1024 * 2816, nb * 32, scr, kb * 64, nb * 32, lane); }
        }
        const int gtid = blockIdx.x * 512 + tid, NT = gridDim.x * 512;
        for (int i = gtid; i < 2 * 96 * 128; i += NT) { const int l = i / (96 * 128), rr = i % (96 * 128);
            *(u32x4*)(WINT + (size_t)l * 3584 * 1024 + (size_t)1952 * 1024 + (size_t)rr * 8) = (u32x4){0u, 0u, 0u, 0u}; }
        u16* LT = (u16*)(ws + OFF_LT);
        for (int i = gtid; i < 2 * LT_PER_LAYER; i += NT) {
            const int l = i / LT_PER_LAYER; int e = i % LT_PER_LAYER; float v;
            if (e < 65536) { const int d = e >> 15, n = (e >> 6) & 511, k = e & 63; v = P.in[I_WUP][((size_t)(l * 2 + d) * 64 + k) * 512 + n]; }
            else if (e < 131072) { const int e2 = e - 65536; const int d = e2 >> 15, n = (e2 >> 6) & 511, k = e2 & 63; v = P.in[I_AUP][((size_t)(l * 2 + d) * 64 + k) * 512 + n]; }
            else { const int e2 = e - 131072; const int n = e2 / 160, k = e2 % 160; v = P.in[I_GUP][((size_t)l * 160 + k) * 512 + n]; }
            LT[i] = f2bf(e < 131072 ? v * -1.44269504089f : v);
        }
    }
    __syncthreads();
    {
        LAS float* zb = (LAS float*)lds;
        LAS float* hb0 = zb + 8 * 36;
        LAS float* hb1 = hb0 + 64 * 8;
        u16* GT = (u16*)(ws + OFF_GT);
        const int p = tid >> 6, j = tid & 63;
        for (int item = blockIdx.x; item < 512; item += gridDim.x) {
            const int l = item >> 8, i0 = (item & 255) * 8, i = i0 + p;
            const float t = (float)i * (1.0f / 2047.0f);
            if (j < 33) {
                float z;
                if (j == 0) z = t;
                else { const int bnd = (j - 1) & 15; const float f = 1e-4f + (float)bnd * ((15.0f - 1e-4f) / 15.0f);
                    const float ang = (6.283185307179586f / 2048.0f) * (float)i * f; z = (j <= 16) ? cosf(ang) : -sinf(ang); }
                zb[p * 36 + j] = z;
            }
            __syncthreads();
            const float fr = P.in[I_FFREQ][l * 64 + j];
            { float a = P.in[I_FB1][l * 64 + j]; const float* w1 = P.in[I_FW1] + (size_t)l * 33 * 64 + j;
#pragma unroll 11
                for (int m = 0; m < 33; ++m) a += zb[p * 36 + m] * w1[m * 64];
                hb0[j * 8 + p] = sinf(fr * a); }
            __syncthreads();
            { float a = P.in[I_FBIN][(l * 2 + 0) * 64 + j]; const float* w = P.in[I_FWIN] + (size_t)(l * 2 + 0) * 4096 + j;
#pragma unroll 16
                for (int m = 0; m < 64; ++m) a += hb0[m * 8 + p] * w[m * 64];
                hb1[j * 8 + p] = sinf(fr * a); }
            __syncthreads();
            { float a = P.in[I_FBIN][(l * 2 + 1) * 64 + j]; const float* w = P.in[I_FWIN] + (size_t)(l * 2 + 1) * 4096 + j;
#pragma unroll 16
                for (int m = 0; m < 64; ++m) a += hb1[m * 8 + p] * w[m * 64];
                a = sinf(fr * a);
                __syncthreads();
                hb0[j * 8 + p] = a; }
            __syncthreads();
#pragma unroll
            for (int qq = 0; qq < 2; ++qq) {
                const int n = j + 64 * (p + 8 * qq);
                float acc8[8];
#pragma unroll
                for (int pp = 0; pp < 8; ++pp) acc8[pp] = 0.f;
                const float* wo = P.in[I_FWOUT] + (size_t)l * 64 * 1024 + n;
#pragma unroll 16
                for (int m = 0; m < 64; ++m) { const float w = wo[m * 1024]; const f32x4 h0 = *(const LAS f32x4*)(hb0 + m * 8), h1 = *(const LAS f32x4*)(hb0 + m * 8 + 4);
                    acc8[0] += h0.x * w; acc8[1] += h0.y * w; acc8[2] += h0.z * w; acc8[3] += h0.w * w; acc8[4] += h1.x * w; acc8[5] += h1.y * w; acc8[6] += h1.z * w; acc8[7] += h1.w * w; }
                const int c = n & 511;
                const float dl = fabsf(-3.0701134573f + (float)c * ((-15.3505672866f + 3.0701134573f) / 511.0f));
                u16* g0 = GT + ((size_t)(l * 512 + c) * 2) * GT_STRIDE; u16* g1 = g0 + GT_STRIDE;
#pragma unroll
                for (int pp = 0; pp < 8; ++pp) {
                    const int ii = i0 + pp; const float tt = (float)ii * (1.0f / 2047.0f);
                    float val = acc8[pp] * expf(-tt * dl);
                    int idx;
                    if (n < 512) { idx = 2048 - ii; if (ii == 0) val += P.in[I_HBIAS][l * 512 + c]; } else { idx = 2048 + ii; }
                    if (n < 512 || ii > 0) { const u16 hv = f2bf(val); g0[idx] = hv; g1[idx - 1] = hv; }
                }
            }
            __syncthreads();
        }
    }
}

template <int MODE> DEVI void phase_ln(const float* xin, const u16* mix, const float* gate, float* dst, const float* g, const float* bta, const float* modsh, const float* modsc, u16* H, int wv) {
    int tid_l = wv * 64 + (int)__lane_id(); asm volatile("" : "+v"(tid_l));
    const int lane = tid_l & 63, wave = tid_l >> 6;
    const int gw = blockIdx.x * 8 + wave, NGW = gridDim.x * 8;
    constexpr int R = 4;
    for (int row0 = gw * R; row0 < MTOK; row0 += NGW * R) {
        const int b = row0 >> 11;
        f32x4 v[R][4]; float s[R], s2[R], mean[R], rstd[R];
#pragma unroll
        for (int r = 0; r < R; ++r) { const f32x4* xr = (const f32x4*)(xin + (size_t)(row0 + r) * 1024) + lane;
#pragma unroll
            for (int j = 0; j < 4; ++j) v[r][j] = __builtin_nontemporal_load(xr + 64 * j); }
        if (MODE >= 1) {
            u32x2 mr[R][4];
#pragma unroll
            for (int r = 0; r < R; ++r) { const u32x2* mp = (const u32x2*)(mix + (size_t)(row0 + r) * 1024) + lane;
#pragma unroll
                for (int j = 0; j < 4; ++j) mr[r][j] = __builtin_nontemporal_load(mp + 64 * j); }
            const f32x4* gp = (const f32x4*)(gate + (size_t)b * 6144) + lane;
#pragma unroll
            for (int j = 0; j < 4; ++j) { const f32x4 gv = gp[64 * j] + 1.0f;
#pragma unroll
                for (int r = 0; r < R; ++r) { const f32x4 mv = (f32x4){bflo(mr[r][j].x), bfhi(mr[r][j].x), bflo(mr[r][j].y), bfhi(mr[r][j].y)};
                    v[r][j] = v[r][j] * ALPHA_ + gv * mv; } }
        }
#pragma unroll
        for (int r = 0; r < R; ++r) { s[r] = 0.f;
#pragma unroll
            for (int j = 0; j < 4; ++j) s[r] += (v[r][j].x + v[r][j].y) + (v[r][j].z + v[r][j].w); }
#pragma unroll
        for (int r = 0; r < R; ++r) mean[r] = wave_sum_dpp(s[r]) * (1.f / 1024.f);
#pragma unroll
        for (int r = 0; r < R; ++r) { s2[r] = 0.f;
#pragma unroll
            for (int j = 0; j < 4; ++j) { v[r][j] = v[r][j] - mean[r]; s2[r] += (v[r][j].x * v[r][j].x + v[r][j].y * v[r][j].y) + (v[r][j].z * v[r][j].z + v[r][j].w * v[r][j].w); } }
#pragma unroll
        for (int r = 0; r < R; ++r) rstd[r] = 1.f / sqrtf(wave_sum_dpp(s2[r]) * (1.f / 1024.f) + LN_EPS_);
        if (MODE >= 1) {
#pragma unroll
            for (int j = 0; j < 4; ++j) { const f32x4 gg = *((const f32x4*)g + lane + 64 * j), bb = *((const f32x4*)bta + lane + 64 * j);
#pragma unroll
                for (int r = 0; r < R; ++r) { v[r][j] = v[r][j] * rstd[r] * gg + bb; __builtin_nontemporal_store(v[r][j], (f32x4*)(dst + (size_t)(row0 + r) * 1024) + lane + 64 * j); } }
            if (MODE == 1) {
#pragma unroll
                for (int r = 0; r < R; ++r) { s[r] = 0.f;
#pragma unroll
                    for (int j = 0; j < 4; ++j) s[r] += (v[r][j].x + v[r][j].y) + (v[r][j].z + v[r][j].w); }
#pragma unroll
                for (int r = 0; r < R; ++r) mean[r] = wave_sum_dpp(s[r]) * (1.f / 1024.f);
#pragma unroll
                for (int r = 0; r < R; ++r) { s2[r] = 0.f;
#pragma unroll
                    for (int j = 0; j < 4; ++j) { v[r][j] = v[r][j] - mean[r]; s2[r] += (v[r][j].x * v[r][j].x + v[r][j].y * v[r][j].y) + (v[r][j].z * v[r][j].z + v[r][j].w * v[r][j].w); } }
#pragma unroll
                for (int r = 0; r < R; ++r) rstd[r] = 1.f / sqrtf(wave_sum_dpp(s2[r]) * (1.f / 1024.f) + LN_EPS_);
            }
        }
        if (MODE <= 1) {
            const f32x4* sh = (const f32x4*)(modsh + (size_t)b * 6144) + lane; const f32x4* sc = (const f32x4*)(modsc + (size_t)b * 6144) + lane;
#pragma unroll
            for (int j = 0; j < 4; ++j) { const f32x4 scv = sc[64 * j] + 1.0f, shv = sh[64 * j];
#pragma unroll
                for (int r = 0; r < R; ++r) { const f32x4 y = v[r][j] * rstd[r] * scv + shv;
                    __builtin_nontemporal_store((unsigned long long)pk2(y.x, y.y) | ((unsigned long long)pk2(y.z, y.w) << 32), (unsigned long long*)(H + (size_t)(row0 + r) * 1024) + lane + 64 * j); } }
        }
    }
}

DEVI void phase_hy_prep(const Params& P, int l, LAS unsigned char* lds, int wv) {
    int tid_l = wv * 64 + (int)__lane_id(); asm volatile("" : "+v"(tid_l));
    unsigned char* ws = launder_ws(P.ws); asm volatile("" : "+s"(l));
    const u16* PH = (const u16*)(ws + OFF_PH); u16* UT = (u16*)(ws + OFF_UT); u16* X0 = (u16*)(ws + OFF_X0);
    const int tsub = tid_l >> 6, c8 = (tid_l & 63) * 8;
    for (int item = blockIdx.x; item < 1024; item += gridDim.x) {
        const int b = item >> 5, t0 = (item & 31) * 64 + tsub * 8;
        const u16* base = PH + ((size_t)b * T_ + t0) * 1536 + c8;
        const bool hp = t0 > 0, hn = (t0 + 8) < T_;
        float u[8][8];
#pragma unroll
        for (int i = 0; i < 3; ++i) {
            float w0[8], w1[8], w2[8], bs[8];
            load8f(P.in[I_HCW] + ((size_t)l * 3 + 0) * 1536 + i * 512 + c8, w0); load8f(P.in[I_HCW] + ((size_t)l * 3 + 1) * 1536 + i * 512 + c8, w1);
            load8f(P.in[I_HCW] + ((size_t)l * 3 + 2) * 1536 + i * 512 + c8, w2); load8f(P.in[I_HCB] + (size_t)l * 1536 + i * 512 + c8, bs);
            u32x4 raw[10];
            raw[0] = *(const u32x4*)(hp ? base - 1536 + i * 512 : base + i * 512);
#pragma unroll
            for (int r = 0; r < 8; ++r) raw[r + 1] = *(const u32x4*)(base + (size_t)r * 1536 + i * 512);
            raw[9] = *(const u32x4*)(hn ? base + (size_t)8 * 1536 + i * 512 : base + i * 512);
            float prev[8], cur[8], nxt[8];
            unpack8(raw[0], prev); unpack8(raw[1], cur);
            if (!hp) {
#pragma unroll
                for (int j = 0; j < 8; ++j) prev[j] = 0.f; }
#pragma unroll
            for (int r = 0; r < 8; ++r) {
                unpack8(raw[r + 2], nxt);
                if (r == 7 && !hn) {
#pragma unroll
                    for (int j = 0; j < 8; ++j) nxt[j] = 0.f; }
                float q[8];
#pragma unroll
                for (int j = 0; j < 8; ++j) { q[j] = w0[j] * prev[j] + w1[j] * cur[j] + w2[j] * nxt[j] + bs[j]; prev[j] = cur[j]; cur[j] = nxt[j]; }
                if (i == 0) *(u32x4*)(X0 + ((size_t)b * T_ + t0 + r) * 512 + c8) = pack8(q);
                else if (i == 1) {
#pragma unroll
                    for (int j = 0; j < 8; ++j) u[r][j] = q[j]; }
                else {
#pragma unroll
                    for (int j = 0; j < 8; ++j) u[r][j] *= q[j]; }
            }
        }
#pragma unroll
        for (int j = 0; j < 8; ++j) { const float col[8] = {u[0][j], u[1][j], u[2][j], u[3][j], u[4][j], u[5][j], u[6][j], u[7][j]};
            *(u32x4*)(UT + ((size_t)(c8 + j) * 32 + b) * T_ + t0) = pack8(col); }
    }
}

DEVI void phase_hy_conv(const Params& P, int l, int wv) {
    int tid_l = wv * 64 + (int)__lane_id(); asm volatile("" : "+v"(tid_l));
    unsigned char* ws = launder_ws(P.ws); asm volatile("" : "+s"(l));
    const int lane = tid_l & 63, wave = __builtin_amdgcn_readfirstlane(tid_l >> 6), r = lane & 31, hh = lane >> 5;
    const u16* GT = (const u16*)(ws + OFF_GT); const u16* UT = (const u16*)(ws + OFF_UT); u16* CONVT = (u16*)(ws + OFF_CONVT);
    const int lanebase = 2048 + 8 * hh - r - 256 * wave;
    const int par = lanebase & 1;
    const unsigned goff = (unsigned)((par * GT_STRIDE + lanebase - par) * 2);
    const unsigned uoff = (unsigned)((r * T_ + 8 * hh) * 2), soff = (unsigned)((r * T_ + 4 * hh) * 2);
    for (int c = blockIdx.x; c < 512; c += gridDim.x) {
        const char* gts = (const char*)(GT + ((size_t)(l * 512 + c) * 2) * GT_STRIDE) - 512;
        const char* utb = (const char*)(UT + (size_t)c * 32 * T_);
        f32x16 acc[8];
#pragma unroll
        for (int m = 0; m < 8; ++m)
#pragma unroll
            for (int i = 0; i < 16; ++i) acc[m][i] = 0.f;
        bf16x8 W[16];
#define HY_LOADF(gb_, e16_) (*(const bf16x8_a4*)((gb_) + goff + 32 * (e16_)))
#define HY_LOADB(ub_, j_) (*(const bf16x8*)((ub_) + uoff + 32 * (j_)))
#pragma unroll
        for (int u = 0; u < 16; ++u) W[u] = (bf16x8){0, 0, 0, 0, 0, 0, 0, 0};
#pragma unroll
        for (int u = 2; u < 16; ++u) W[u] = HY_LOADF(gts, u);
        bf16x8 wn0 = HY_LOADF(gts, 16), wn1 = HY_LOADF(gts, 17);
        bf16x8 bn0 = HY_LOADB(utb, 0), bn1 = HY_LOADB(utb, 1);
        for (int jj = 0; jj < 8; ++jj) {
            const char* gj = gts + 512 * jj; const char* uj = utb + 512 * jj;
#pragma unroll
            for (int u = 0; u < 16; ++u) {
                bf16x8 bfr;
                if ((u & 1) == 0) { W[u] = wn0; bfr = bn0; wn0 = HY_LOADF(gj, u + 18); bn0 = HY_LOADB(uj, u + 2); }
                else { W[u] = wn1; bfr = bn1; wn1 = HY_LOADF(gj, u + 18); bn1 = HY_LOADB(uj, u + 2); }
#pragma unroll
                for (int m = 0; m < 8; ++m) acc[m] = __builtin_amdgcn_mfma_f32_32x32x16_bf16(W[(u - 2 * m) & 15], bfr, acc[m], 0, 0, 0);
            }
        }
#undef HY_LOADF
#undef HY_LOADB
        char* cb = (char*)(CONVT + (size_t)c * 32 * T_) + 512 * wave;
#pragma unroll
        for (int m = 0; m < 8; ++m) {
#pragma unroll
            for (int q = 0; q < 4; ++q) { u32x2 o; o.x = pk2(acc[m][4 * q], acc[m][4 * q + 1]); o.y = pk2(acc[m][4 * q + 2], acc[m][4 * q + 3]);
                *(u32x2*)(cb + soff + (64 * m + 16 * q)) = o; } }
    }
}

DEVI void phase_hy_post(const Params& P, LAS unsigned char* lds, int wv) {
    int tid_l = wv * 64 + (int)__lane_id(); asm volatile("" : "+v"(tid_l));
    unsigned char* ws = launder_ws(P.ws);
    const u16* CONVT = (const u16*)(ws + OFF_CONVT); const u16* X0 = (const u16*)(ws + OFF_X0); u16* YM = (u16*)(ws + OFF_A);
    const int tsub = tid_l >> 6, c8 = (tid_l & 63) * 8;
    for (int item = blockIdx.x; item < 1024; item += gridDim.x) {
        const int b = item >> 5, t0 = (item & 31) * 64 + tsub * 8;
        u32x4 cv[8], xv[8];
#pragma unroll
        for (int j = 0; j < 8; ++j) cv[j] = *(const u32x4*)(CONVT + ((size_t)(c8 + j) * 32 + b) * T_ + t0);
#pragma unroll
        for (int r = 0; r < 8; ++r) xv[r] = *(const u32x4*)(X0 + ((size_t)b * T_ + t0 + r) * 512 + c8);
        float cf[8][8];
#pragma unroll
        for (int j = 0; j < 8; ++j) unpack8(cv[j], cf[j]);
#pragma unroll
        for (int r = 0; r < 8; ++r) { float x[8], o[8]; unpack8(xv[r], x);
#pragma unroll
            for (int j = 0; j < 8; ++j) o[j] = x[j] * cf[j][r];
            *(u32x4*)(YM + ((size_t)b * T_ + t0 + r) * 1024 + 512 + c8) = pack8(o); }
    }
}

DEVI void phase_rwkv_prep(const Params& P, int l, int wv) {
    int tid_l = wv * 64 + (int)__lane_id(); asm volatile("" : "+v"(tid_l));
    unsigned char* ws = launder_ws(P.ws); asm volatile("" : "+s"(l));
    const int lane = tid_l & 63, wave = tid_l >> 6, r = lane & 31, hh = lane >> 5;
    const int gw = blockIdx.x * 8 + wave, NGW = gridDim.x * 8;
    const u16* PR = (const u16*)(ws + OFF_PR);
    const u16* LT = (const u16*)(ws + OFF_LT) + (size_t)l * LT_PER_LAYER;
    const float* mup = P.in[I_MUP] + l * 1952; const float* mun = P.in[I_MUN] + l * 1952;
    for (int it = gw; it < 2048 * 5; it += NGW) {
        const int mat = it % 5, tok0 = (it / 5) * 32, tok = tok0 + r, t = tok & 2047;
        const int K = (mat == 4) ? 160 : 64, cbase = (mat == 4) ? 1792 : 1536 + 64 * mat;
        const u16* pr = PR + (size_t)tok * 2048 + cbase + 8 * hh;
        bf16x8 af[10];
#pragma unroll
        for (int kk = 0; kk < 10; ++kk) {
            af[kk] = (bf16x8){0, 0, 0, 0, 0, 0, 0, 0};
            if (kk * 16 < K) {
                float pc[8], pp[8], pn[8], mp[8], mn[8], x[8];
                unpack8(*(const u32x4*)(pr + kk * 16), pc);
                if (t > 0) unpack8(*(const u32x4*)(pr + kk * 16 - 2048), pp); else {
#pragma unroll
                    for (int q = 0; q < 8; ++q) pp[q] = 0.f; }
                if (t < T_ - 1) unpack8(*(const u32x4*)(pr + kk * 16 + 2048), pn); else {
#pragma unroll
                    for (int q = 0; q < 8; ++q) pn[q] = 0.f; }
                load8f(mup + cbase + 8 * hh + kk * 16, mp); load8f(mun + cbase + 8 * hh + kk * 16, mn);
#pragma unroll
                for (int q = 0; q < 8; ++q) { float v = pc[q] + mp[q] * (pp[q] - pc[q]) + mn[q] * (pn[q] - pc[q]);
                    if (mat < 2) v = tanhf_(v); else if (mat == 4) v = sigmoidf_(v);
                    x[q] = v; }
                const u32x4 pk = pack8(x);
                af[kk] = __builtin_bit_cast(bf16x8, pk);
            }
        }
        const u16* lt = (mat < 2) ? LT + (size_t)mat * 32768 : (mat < 4) ? LT + 65536 + (size_t)(mat - 2) * 32768 : LT + 131072;
        const float* bias = (mat < 2) ? P.in[I_W0] + (size_t)(l * 2 + mat) * 512 : P.in[I_A0] + (size_t)(l * 2 + (mat & 1)) * 512;
        u16* outp = (u16*)(ws + (mat == 0 ? OFF_EF : mat == 1 ? OFF_EB : mat == 2 ? OFF_AF : mat == 3 ? OFF_AB : OFF_G));
#define GLOAD16(dst_, ptr_) asm volatile("global_load_dwordx4 %0, %1, off" : "=v"(dst_) : "v"(ptr_) : "memory")
        u32x4 fn[10], fc[10]; f32x4 bn[4], bc[4];
#pragma unroll
        for (int kk = 0; kk < 10; ++kk) { fn[kk] = (u32x4){0u, 0u, 0u, 0u}; fc[kk] = fn[kk]; }
#pragma unroll
        for (int q = 0; q < 4; ++q) { bn[q] = (f32x4){0.f, 0.f, 0.f, 0.f}; bc[q] = bn[q]; }
        { const u16* bp = lt + (size_t)r * K + 8 * hh;
#pragma unroll
          for (int kk = 0; kk < 10; ++kk) if (kk * 16 < K) GLOAD16(fn[kk], bp + kk * 16);
          if (mat < 4) {
#pragma unroll
              for (int q = 0; q < 4; ++q) GLOAD16(bn[q], bias + 8 * q + 4 * hh); } }
        asm volatile("s_waitcnt vmcnt(0)" ::: "memory");
        for (int nt = 0; nt < 16; ++nt) {
#pragma unroll
            for (int kk = 0; kk < 10; ++kk) fc[kk] = fn[kk];
#pragma unroll
            for (int q = 0; q < 4; ++q) bc[q] = bn[q];
            asm volatile("" ::: "memory");
            if (nt + 1 < 16) { const u16* bp = lt + (size_t)((nt + 1) * 32 + r) * K + 8 * hh;
#pragma unroll
                for (int kk = 0; kk < 10; ++kk) if (kk * 16 < K) GLOAD16(fn[kk], bp + kk * 16);
                if (mat < 4) {
#pragma unroll
                    for (int q = 0; q < 4; ++q) GLOAD16(bn[q], bias + (nt + 1) * 32 + 8 * q + 4 * hh); } }
            f32x16 acc;
#pragma unroll
            for (int q = 0; q < 4; ++q)
#pragma unroll
                for (int e = 0; e < 4; ++e) acc[4 * q + e] = bc[q][e] * -1.44269504089f;
#pragma unroll
            for (int kk = 0; kk < 10; ++kk) if (kk * 16 < K) acc = __builtin_amdgcn_mfma_f32_32x32x16_bf16(__builtin_bit_cast(bf16x8, fc[kk]), af[kk], acc, 0, 0, 0);
            unsigned pkd[4][2];
#pragma unroll
            for (int q = 0; q < 4; ++q) {
                float o[4];
#pragma unroll
                for (int e = 0; e < 4; ++e) { const float x = acc[4 * q + e]; o[e] = (mat < 4) ? __builtin_amdgcn_rcpf(1.f + __builtin_amdgcn_exp2f(x)) : x; }
                pkd[q][0] = pk2(o[0], o[1]); pkd[q][1] = pk2(o[2], o[3]);
            }
#pragma unroll
            for (int p = 0; p < 2; ++p) {
                asm volatile("s_nop 1\n\tv_permlane32_swap_b32 %0, %1" : "+v"(pkd[2 * p][0]), "+v"(pkd[2 * p + 1][0]));
                asm volatile("s_nop 1\n\tv_permlane32_swap_b32 %0, %1" : "+v"(pkd[2 * p][1]), "+v"(pkd[2 * p + 1][1]));
                u32x4 w; w.x = pkd[2 * p][0]; w.y = pkd[2 * p][1]; w.z = pkd[2 * p + 1][0]; w.w = pkd[2 * p + 1][1];
                *(u32x4*)(outp + (size_t)(tok0 + r) * 512 + nt * 32 + 16 * p + 8 * hh) = w;
            }
            asm volatile("s_waitcnt vmcnt(2)" ::: "memory");
        }
        asm volatile("s_waitcnt vmcnt(0)" ::: "memory");
#undef GLOAD16
    }
}

DEVI void phase_scan(const Params& P, int l, LAS unsigned char* lds, int wv) {
    int tid_l = wv * 64 + (int)__lane_id(); asm volatile("" : "+v"(tid_l));
    unsigned char* ws = launder_ws(P.ws); asm volatile("" : "+s"(l));
    const int lane = tid_l & 63, wave = __builtin_amdgcn_readfirstlane(tid_l >> 6);
    constexpr int NS = 16, NSET = 2048 / NS, VEC = 6 * 64;
    LAS float* ring = (LAS float*)lds;
    const u16* PR = (const u16*)(ws + OFF_PR);
    const int dir = wave >> 2, rq = wave & 3, jrow = lane & 15;
    for (int bh = blockIdx.x; bh < 256; bh += gridDim.x) {
        const int b = bh >> 3, h = bh & 7, col = h * 64 + lane;
        const u16* prow = PR + (size_t)b * T_ * 2048 + h * 64;
        const float* mup = P.in[I_MUP] + l * 1952; const float* mun = P.in[I_MUN] + l * 1952;
        const float mpr = mup[col], mnr = mun[col], mpk = mup[512 + col], mnk = mun[512 + col], mpv = mup[1024 + col], mnv = mun[1024 + col];
        const float kkw = P.in[I_KK][l * 512 + col], kaw = P.in[I_KA][l * 512 + col];
        const u16* Ep = (const u16*)(ws + (dir ? OFF_EB : OFF_EF)) + (size_t)b * T_ * 512 + h * 64;
        const u16* Ap = (const u16*)(ws + (dir ? OFF_AB : OFF_AF)) + (size_t)b * T_ * 512 + h * 64;
        u16* Yp = (u16*)(ws + (dir ? OFF_YB : OFF_YF)) + (size_t)b * T_ * 512 + h * 64 + 16 * rq + 2 * (lane >> 3);
        f32x2 S2[2][4];
#pragma unroll
        for (int i = 0; i < 2; ++i)
#pragma unroll
            for (int c = 0; c < 4; ++c) S2[i][c] = (f32x2){0.f, 0.f};
        const float mAr = dir ? mnr : mpr, mBr = dir ? mpr : mnr, mAk = dir ? mnk : mpk, mBk = dir ? mpk : mnk, mAv = dir ? mnv : mpv, mBv = dir ? mpv : mnv;
        unsigned rwr[6][3], rwe[4], rwa[4];
#define SCAN_ISSUE(set_) do { const int s0_ = (set_) * NS + 4 * rq; \
            _Pragma("unroll") for (int ix = 0; ix < 6; ++ix) { int pos = s0_ - 1 + ix; pos = pos < 0 ? 0 : (pos > 2047 ? 2047 : pos); const int tm = dir ? 2047 - pos : pos; \
                const u16* pc = prow + (size_t)tm * 2048; rwr[ix][0] = pc[lane]; rwr[ix][1] = pc[512 + lane]; rwr[ix][2] = pc[1024 + lane]; } \
            _Pragma("unroll") for (int q = 0; q < 4; ++q) { const int pos = s0_ + q; const int tm = dir ? 2047 - pos : pos; \
                rwe[q] = Ep[(size_t)tm * 512 + lane]; rwa[q] = Ap[(size_t)tm * 512 + lane]; } } while (0)
#define SCAN_PRODUCE(set_) do { const int s0_ = (set_) * NS + 4 * rq; \
            _Pragma("unroll") for (int q = 0; q < 4; ++q) { \
            const int st = 4 * rq + q, pos = s0_ + q; \
            const float fA = pos > 0 ? 1.f : 0.f, fB = pos < 2047 ? 1.f : 0.f; \
            const float c0 = bf2f(rwr[q + 1][0]), c1 = bf2f(rwr[q + 1][1]), c2 = bf2f(rwr[q + 1][2]); \
            const float r_ = c0 + mAr * (fA * bf2f(rwr[q][0]) - c0) + mBr * (fB * bf2f(rwr[q + 2][0]) - c0); \
            const float k_ = c1 + mAk * (fA * bf2f(rwr[q][1]) - c1) + mBk * (fB * bf2f(rwr[q + 2][1]) - c1); \
            const float v_ = c2 + mAv * (fA * bf2f(rwr[q][2]) - c2) + mBv * (fB * bf2f(rwr[q + 2][2]) - c2); \
            const float kkv = k_ * kkw; const float ss = wave_sum_dpp(kkv * kkv); \
            const float kkn = kkv * __builtin_amdgcn_rsqf(fmaxf(ss, 1e-24f)); \
            const float a_ = bf2f(rwa[q]), w_ = __builtin_amdgcn_exp2f(bf2f(rwe[q]) * (-0.60653065971f * 1.44269504089f)); \
            LAS float* o = ring + ((((set_) & 1) * 2 + dir) * NS + st) * VEC + lane; \
            o[0] = -kkn; o[64] = w_; o[128] = kkn * a_; o[192] = k_ * (1.f + (a_ - 1.f) * kaw); o[256] = r_; o[320] = v_; } } while (0)
        SCAN_ISSUE(0);
        SCAN_PRODUCE(0);
        SCAN_ISSUE(1);
        __syncthreads();
        for (int set = 0; set < NSET; ++set) {
            if (set + 1 < NSET) SCAN_PRODUCE(set + 1);
            if (set + 2 < NSET) SCAN_ISSUE(set + 2);
            const LAS float* sb = ring + ((set & 1) * 2 + dir) * NS * VEC + 8 * (lane & 7);
            const int voff = 320 + 16 * rq + 2 * (lane >> 3) - 8 * (lane & 7);
#pragma unroll 2
            for (int st = 0; st < NS; ++st) {
                const LAS float* sm = sb + st * VEC;
                const f32x2 vv = *(const LAS f32x2*)(sm + voff);
                const f32x4 z0 = *(const LAS f32x4*)(sm), z1 = *(const LAS f32x4*)(sm + 4), w0 = *(const LAS f32x4*)(sm + 64), w1 = *(const LAS f32x4*)(sm + 68),
                            b0 = *(const LAS f32x4*)(sm + 128), b1 = *(const LAS f32x4*)(sm + 132), d0 = *(const LAS f32x4*)(sm + 192), d1 = *(const LAS f32x4*)(sm + 196),
                            r0 = *(const LAS f32x4*)(sm + 256), r1 = *(const LAS f32x4*)(sm + 260);
                const f32x2 zp[4] = {(f32x2){z0.x, z0.y}, (f32x2){z0.z, z0.w}, (f32x2){z1.x, z1.y}, (f32x2){z1.z, z1.w}};
                const f32x2 wp[4] = {(f32x2){w0.x, w0.y}, (f32x2){w0.z, w0.w}, (f32x2){w1.x, w1.y}, (f32x2){w1.z, w1.w}};
                const f32x2 bp[4] = {(f32x2){b0.x, b0.y}, (f32x2){b0.z, b0.w}, (f32x2){b1.x, b1.y}, (f32x2){b1.z, b1.w}};
                const f32x2 dp[4] = {(f32x2){d0.x, d0.y}, (f32x2){d0.z, d0.w}, (f32x2){d1.x, d1.y}, (f32x2){d1.z, d1.w}};
                const f32x2 rp[4] = {(f32x2){r0.x, r0.y}, (f32x2){r0.z, r0.w}, (f32x2){r1.x, r1.y}, (f32x2){r1.z, r1.w}};
                f32x2 sA = S2[0][0] * zp[0] + S2[0][1] * zp[1], sB = S2[0][2] * zp[2] + S2[0][3] * zp[3];
                f32x2 sC = S2[1][0] * zp[0] + S2[1][1] * zp[1], sD = S2[1][2] * zp[2] + S2[1][3] * zp[3];
                const f32x2 s0v = sA + sB, s1v = sC + sD;
                float sz0 = s0v.x + s0v.y, sz1 = s1v.x + s1v.y; red8x2(sz0, sz1);
                const f32x2 z0v = (f32x2){sz0, sz0}, z1v = (f32x2){sz1, sz1}, vxv = (f32x2){vv.x, vv.x}, vyv = (f32x2){vv.y, vv.y};
                f32x2 yA = (f32x2){0.f, 0.f}, yB = yA;
#pragma unroll
                for (int c = 0; c < 4; ++c) {
                    S2[0][c] = S2[0][c] * wp[c] + z0v * bp[c] + vxv * dp[c]; yA += S2[0][c] * rp[c];
                    S2[1][c] = S2[1][c] * wp[c] + z1v * bp[c] + vyv * dp[c]; yB += S2[1][c] * rp[c];
                }
                const float ya0 = yA.x, yb0 = yA.y, ya1 = yB.x, yb1 = yB.y;
                float y0 = ya0 + yb0, y1 = ya1 + yb1; red8x2(y0, y1);
                const int s_ = set * NS + st, tm = dir ? 2047 - s_ : s_;
                if ((lane & 7) == 0) *(unsigned*)(Yp + (size_t)tm * 512) = pk2(y0, y1);
            }
            LDS_WAIT(); __builtin_amdgcn_s_barrier();
        }
#undef SCAN_ISSUE
#undef SCAN_PRODUCE
    }
}

DEVI void phase_rwkv_post(const Params& P, int l, int wv) {
    int tid_l = wv * 64 + (int)__lane_id(); asm volatile("" : "+v"(tid_l));
    unsigned char* ws = launder_ws(P.ws); asm volatile("" : "+s"(l));
    const int lane = tid_l & 63, wave = tid_l >> 6;
    const int gw = blockIdx.x * 8 + wave, NGW = gridDim.x * 8;
    const int ch0 = lane * 8;
    const u16* PR = (const u16*)(ws + OFF_PR); const u16* AF = (const u16*)(ws + OFF_AF); const u16* AB = (const u16*)(ws + OFF_AB);
    const u16* G = (const u16*)(ws + OFF_G); const u16* YF = (const u16*)(ws + OFF_YF); const u16* YB = (const u16*)(ws + OFF_YB);
    u16* YM = (u16*)(ws + OFF_A);
    float mp[3][8], mn[3][8], ka[8], gw_[8], gb_[8], rk[8];
#pragma unroll
    for (int i = 0; i < 3; ++i) { load8f(P.in[I_MUP] + l * 1952 + i * 512 + ch0, mp[i]); load8f(P.in[I_MUN] + l * 1952 + i * 512 + ch0, mn[i]); }
    load8f(P.in[I_KA] + l * 512 + ch0, ka); load8f(P.in[I_GNW] + l * 512 + ch0, gw_); load8f(P.in[I_GNB] + l * 512 + ch0, gb_); load8f(P.in[I_RK] + l * 512 + ch0, rk);
    u32x4 cu[14], nx[14];
#define RP_LOAD(D_, tok_) do { const int t_ = (tok_) & 2047; const u16* q_ = PR + (size_t)(tok_) * 2048 + ch0; \
        _Pragma("unroll") for (int i = 0; i < 3; ++i) { D_[3 * i] = *(const u32x4*)(q_ + i * 512); D_[3 * i + 1] = *(const u32x4*)(q_ + i * 512 - (t_ > 0 ? 2048 : 0)); D_[3 * i + 2] = *(const u32x4*)(q_ + i * 512 + (t_ < T_ - 1 ? 2048 : 0)); } \
        D_[9] = *(const u32x4*)(AF + (size_t)(tok_) * 512 + ch0); D_[10] = *(const u32x4*)(AB + (size_t)(tok_) * 512 + ch0); D_[11] = *(const u32x4*)(G + (size_t)(tok_) * 512 + ch0); \
        D_[12] = *(const u32x4*)(YF + (size_t)(tok_) * 512 + ch0); D_[13] = *(const u32x4*)(YB + (size_t)(tok_) * 512 + ch0); } while (0)
    if (gw < MTOK) RP_LOAD(cu, gw);
    for (int tok = gw; tok < MTOK; tok += NGW) {
        const int t = tok & 2047;
        const int tn = tok + NGW < MTOK ? tok + NGW : tok;
        RP_LOAD(nx, tn);
        const float fp = t > 0 ? 1.f : 0.f, fn = t < T_ - 1 ? 1.f : 0.f;
        float x[3][8];
#pragma unroll
        for (int i = 0; i < 3; ++i) { float pc[8], pp[8], pn[8]; unpack8(cu[3 * i], pc); unpack8(cu[3 * i + 1], pp); unpack8(cu[3 * i + 2], pn);
#pragma unroll
            for (int j = 0; j < 8; ++j) x[i][j] = pc[j] + mp[i][j] * (fp * pp[j] - pc[j]) + mn[i][j] * (fn * pn[j] - pc[j]); }
        float af[8], ab[8], g[8], yf[8], yb[8], y[8];
        unpack8(cu[9], af); unpack8(cu[10], ab); unpack8(cu[11], g); unpack8(cu[12], yf); unpack8(cu[13], yb);
        float s = 0.f;
#pragma unroll
        for (int j = 0; j < 8; ++j) { y[j] = yf[j] + yb[j]; s += y[j]; }
        const float mean = red8(s) * (1.f / 64.f); float s2 = 0.f, bs = 0.f;
#pragma unroll
        for (int j = 0; j < 8; ++j) { y[j] -= mean; s2 += y[j] * y[j];
            const float ks = x[1][j] * (2.f + (af[j] + ab[j] - 2.f) * ka[j]); bs += x[0][j] * ks * rk[j]; }
        const float rstd = __builtin_amdgcn_rsqf(red8(s2) * (1.f / 64.f) + GN_EPS_);
        bs = red8(bs);
        float o[8];
#pragma unroll
        for (int j = 0; j < 8; ++j) o[j] = (y[j] * rstd * gw_[j] + gb_[j] + bs * x[2][j]) * g[j];
        *(u32x4*)(YM + (size_t)tok * 1024 + ch0) = pack8(o);
#pragma unroll
        for (int i = 0; i < 14; ++i) cu[i] = nx[i];
    }
#undef RP_LOAD
}

DEVI void phase_act(const Params& P, int l, size_t dst_off, int wrap_mask, int wv) {
    int tid_l = wv * 64 + (int)__lane_id(); asm volatile("" : "+v"(tid_l));
    unsigned char* ws = launder_ws(P.ws); asm volatile("" : "+s"(l));
    const int gtid = blockIdx.x * 512 + tid_l, NT = gridDim.x * 512;
    u16* UA = (u16*)(ws + OFF_UA); const u16* UG = (const u16*)(ws + OFF_UG); u16* UD = (u16*)(ws + dst_off);
    for (int idx = gtid; idx < 8192 * 352; idx += NT) {
        const int chunk = idx / 352, cg8 = (idx % 352) * 8, tok0 = chunk * 8, t0 = tok0 & 2047;
        float w0[8], w1[8], w2[8], bs[8];
        load8f(P.in[I_FCW] + ((size_t)l * 3 + 0) * 2816 + cg8, w0); load8f(P.in[I_FCW] + ((size_t)l * 3 + 1) * 2816 + cg8, w1);
        load8f(P.in[I_FCW] + ((size_t)l * 3 + 2) * 2816 + cg8, w2); load8f(P.in[I_FCB] + (size_t)l * 2816 + cg8, bs);
        const u16* ug = UG + (size_t)tok0 * 2816 + cg8; const u16* ua = UA + (size_t)tok0 * 2816 + cg8;
        u32x4 gr[10], ar[8];
        const bool hp = t0 > 0, hn = (t0 + 8) < T_;
        gr[0] = *(const u32x4*)(hp ? ug - 2816 : ug);
#pragma unroll
        for (int i = 0; i < 8; ++i) { gr[i + 1] = *(const u32x4*)(ug + (size_t)i * 2816); ar[i] = *(const u32x4*)(ua + (size_t)i * 2816); }
        gr[9] = *(const u32x4*)(hn ? ug + (size_t)8 * 2816 : ug);
        if (!hp) gr[0] = (u32x4){0u, 0u, 0u, 0u};
        if (!hn) gr[9] = (u32x4){0u, 0u, 0u, 0u};
        float prev[8], cur[8], nxt[8];
        unpack8(gr[0], prev); unpack8(gr[1], cur);
#pragma unroll
        for (int i = 0; i < 8; ++i) {
            unpack8(gr[i + 2], nxt);
            float a[8], o[8]; unpack8(ar[i], a);
#pragma unroll
            for (int j = 0; j < 8; j += 2) {
                f32x2 u = (f32x2){w0[j] * prev[j] + w1[j] * cur[j] + w2[j] * nxt[j] + bs[j], w0[j + 1] * prev[j + 1] + w1[j + 1] * cur[j + 1] + w2[j + 1] * nxt[j + 1] + bs[j + 1]};
                const f32x2 gl = pg8::gelu_pk(u); o[j] = gl.x * a[j]; o[j + 1] = gl.y * a[j + 1]; }
            *(u32x4*)(UD + (size_t)((tok0 + i) & wrap_mask) * 2816 + cg8) = pack8(o);
#pragma unroll
            for (int j = 0; j < 8; ++j) { prev[j] = cur[j]; cur[j] = nxt[j]; }
        }
    }
}

#define LAUNDER_WS() unsigned char* ws = launder_ws(P.ws); asm volatile("" : "+s"(l)); float* MOD = (float*)(ws + OFF_MOD); u16* HA = (u16*)(ws + OFF_A); const float* modl = MOD + (size_t)l * 32 * 6144; (void)modl; (void)HA
#ifndef DUP
#define DUP 0
#endif
#define REP(mask_) for (int rep_ = 0; rep_ < ((DUP & (mask_)) ? 2 : 1); ++rep_)
__global__ void __launch_bounds__(512, 2) mega_fwd(Params P) {
    extern __shared__ __attribute__((aligned(16))) unsigned char smem_[];
    LAS unsigned char* lds = (LAS unsigned char*)smem_;
    cg::grid_group grid = cg::this_grid();
    const int wv = __builtin_amdgcn_readfirstlane((int)threadIdx.x >> 6);
    volatile LAS unsigned* xst = (volatile LAS unsigned*)(lds + 131072);
    if (wv == 0 && __lane_id() == 0) { xst[0] = 0u; xst[1] = 0u; xst[2] = 0u; xst[3] = 0u; }
    __syncthreads();
    if (wv == 0 && __lane_id() == 0) (void)xb_add(&((unsigned*)P.ws)[XB_XCNT(xb_xcc_id())], 1u);
#define GSYNC() do { XcdBarrier b_; b_.bar = (unsigned*)launder_ws(P.ws); b_.x = xb_xcc_id(); b_.st = (volatile LAS unsigned*)(lds + 131072); xcd_barrier(b_, wv == 0 && __lane_id() == 0); } while (0)
    REP(16) phase_prologue(P, lds, wv);
    grid.sync();
    if (DUP & 32) { for (int i = 0; i < 20; ++i) GSYNC(); }
    REP(16) { int l = 0; LAUNDER_WS(); phase_ln<0>(P.in[I_X], nullptr, nullptr, nullptr, nullptr, nullptr, MOD + 0 * 1024, MOD + 1 * 1024, HA, wv); }
    GSYNC();
#pragma nounroll
    for (int l = 0; l < 2; ++l) {
        REP(1) { LAUNDER_WS(); EpiSplitBf16 E; E.O0 = (u16*)(ws + OFF_PR); E.O1 = (u16*)(ws + OFF_PH); E.nsplit = 8; E.ld0 = 2048; E.ld1 = 1536;
          run_gemm(lds, HA, (const u16*)(ws + OFF_WINT) + (size_t)l * 3584 * 1024, 3584, 1024, E, wv); }
        GSYNC();
        REP(4) phase_hy_prep(P, l, lds, wv);
        GSYNC();
        REP(4 | 64) phase_hy_conv(P, l, wv);
        GSYNC();
        REP(4) phase_hy_post(P, lds, wv);
        GSYNC();
        REP(8 | 128) phase_rwkv_prep(P, l, wv);
        GSYNC();
        REP(2) phase_scan(P, l, lds, wv);
        GSYNC();
        REP(8) phase_rwkv_post(P, l, wv);
        GSYNC();
        { LAUNDER_WS(); EpiSplitBf16 E; E.O0 = (u16*)(ws + OFF_B); E.O1 = E.O0; E.nsplit = 4; E.ld0 = 1024; E.ld1 = 1024;
          run_gemm(lds, HA, (const u16*)(ws + OFF_WOT) + (size_t)l * 1024 * 1024, 1024, 1024, E, wv); }
        GSYNC();
        { LAUNDER_WS(); phase_ln<1>((l == 0) ? P.in[I_X] : P.out, (const u16*)(ws + OFF_B), modl + 2 * 1024, P.out, P.in[I_LMG] + l * 1024, P.in[I_LMB] + l * 1024, modl + 3 * 1024, modl + 4 * 1024, HA, wv); }
        GSYNC();
        REP(1) { LAUNDER_WS(); EpiSplitBf16 E; E.O0 = (u16*)(ws + OFF_UA); E.O1 = (u16*)(ws + OFF_UG); E.nsplit = 11; E.ld0 = 2816; E.ld1 = 2816;
          run_gemm(lds, HA, (const u16*)(ws + OFF_WUT) + (size_t)l * 5632 * 1024, 5632, 1024, E, wv); }
        GSYNC();
        if (DUP & 512) phase_act(P, l, OFF_B + 704 * MiB, 16383, wv);
        phase_act(P, l, OFF_UA, 0x7fffffff, wv);
        GSYNC();
        { LAUNDER_WS(); EpiSplitBf16 E; E.O0 = HA; E.O1 = HA; E.nsplit = 4; E.ld0 = 1024; E.ld1 = 1024;
          run_gemm(lds, (const u16*)(ws + OFF_UA), (const u16*)(ws + OFF_WDT) + (size_t)l * 1024 * 2816, 1024, 2816, E, wv); }
        GSYNC();
        { LAUNDER_WS();
          if (l == 0) phase_ln<1>(P.out, HA, modl + 5 * 1024, P.out, P.in[I_LFG], P.in[I_LFB], MOD + (size_t)32 * 6144 + 0 * 1024, MOD + (size_t)32 * 6144 + 1 * 1024, HA, wv);
          else phase_ln<2>(P.out, HA, modl + 5 * 1024, P.out, P.in[I_LFG] + 1024, P.in[I_LFB] + 1024, nullptr, nullptr, nullptr, wv); }
        if (l == 0) GSYNC();
    }
#undef GSYNC
}

extern "C" void kernel_launch(void* const* d_in, const int* in_sizes, int n_in, void* d_out, int out_size, void* d_ws, size_t ws_size, hipStream_t stream) {
    static int grid = 0;
    constexpr int LDS_BYTES = 131072 + 16;
    if (grid == 0) {
        if (n_in != 36 || out_size != MTOK * 1024 || ws_size < WS_NEED) { fprintf(stderr, "kernel_launch: unexpected shapes (n_in %d out %d ws %zu)\n", n_in, out_size, ws_size); grid = -1; return; }
        int dev = 0, cus = 0, per_cu = 0;
        hipGetDevice(&dev); hipDeviceGetAttribute(&cus, hipDeviceAttributeMultiprocessorCount, dev);
        hipFuncSetAttribute((const void*)mega_fwd, hipFuncAttributeMaxDynamicSharedMemorySize, LDS_BYTES);
        hipOccupancyMaxActiveBlocksPerMultiprocessor(&per_cu, (const void*)mega_fwd, 512, LDS_BYTES);
        if (per_cu < 1) { fprintf(stderr, "kernel_launch: occupancy query says %d blocks/CU\n", per_cu); per_cu = 1; }
        grid = cus;
        (void)hipGetLastError();
    }
    if (grid < 0) return;
    if (hipMemsetAsync(d_ws, 0, 16384, stream) != hipSuccess) { fprintf(stderr, "kernel_launch: memset of the barrier words failed\n"); return; }
    Params p{};
    for (int i = 0; i < 36; ++i) p.in[i] = (const float*)d_in[i];
    p.out = (float*)d_out; p.ws = (unsigned char*)d_ws;
    void* args[] = {&p};
    hipError_t e = hipLaunchCooperativeKernel((const void*)mega_fwd, dim3(grid), dim3(512), args, LDS_BYTES, stream);
    if (e != hipSuccess) fprintf(stderr, "cooperative launch failed: %s (grid %d)\n", hipGetErrorString(e), grid);
}
```

```cpp
#include <hip/hip_runtime.h>
#include <hip/hip_cooperative_groups.h>
#include <cstdio>
#include <cstdint>
namespace cg = cooperative_groups;
namespace pg8 {
#define PG8_LAS __attribute__((address_space(3)))
typedef unsigned short bf16_t;
typedef short bf16x8 __attribute__((ext_vector_type(8)));
typedef float f32x4 __attribute__((ext_vector_type(4)));
typedef unsigned u32x4 __attribute__((ext_vector_type(4)));
constexpr int BM = 256, BK = 64, HALF = 128, HTB = HALF * BK * 2  , STAGE_BYTES = 8 * HTB, NXCD = 8, WGM = 4;

__host__ __device__ __forceinline__ int lds_byte(int r, int c) { const int st = (r >> 4) * 2 + (c >> 5), rr = r & 15, cc = c & 31, ob = rr * 64 + cc * 2; return st * 1024 + (ob ^ (((ob >> 9) & 1) << 5)); }
__host__ __device__ __forceinline__ void stage_rc(int b, int& R, int& C) { const int st = b / 1024, sb = b % 1024, swz = sb ^ (((sb >> 9) & 1) << 5); R = (st >> 1) * 16 + swz / 64; C = (st & 1) * 32 + (swz % 64) / 2; }
__host__ __device__ __forceinline__ int perm32(int rho) { const int n = rho >> 4, i = rho & 15; return 8 * (i >> 2) + 4 * n + (i & 3); }

struct Unit { int pm, pn; };
struct Gemm { const bf16_t* A; const bf16_t* Bt; int M, N, K; };

struct StaticOrder {
    int nM, nN, nwg, G, c;
    __host__ __device__ void init(int M, int N, int G_, int c_) { nM = M / BM; nN = N / BM; nwg = nM * nN; G = G_; c = c_; }
    __host__ __device__ bool next(int i, Unit& u) const {
        const long L = (long)i * G + c; if (L >= nwg) return false;
        int wgid = (int)L; { const int q = nwg / NXCD, r = nwg % NXCD, xcd = wgid % NXCD, off = wgid / NXCD; wgid = (xcd < r ? xcd * (q + 1) : r * (q + 1) + (xcd - r) * q) + off; }
        const int nig = WGM * nN, gid = wgid / nig, fm = gid * WGM, gsz = (nM - fm) < WGM ? (nM - fm) : WGM;
        u.pm = fm + ((wgid % nig) % gsz); u.pn = (wgid % nig) / gsz; return true;
    }
    __device__ __forceinline__ void a_ready(const Unit&) const {}
    __device__ __forceinline__ void done(const Unit&) const {}
};
__device__ __forceinline__ unsigned cvt_pk_bf16(float lo, float hi) { unsigned r; asm volatile("v_cvt_pk_bf16_f32 %0, %1, %2" : "=v"(r) : "v"(lo), "v"(hi)); return r; }
typedef float f32x2 __attribute__((ext_vector_type(2)));
__device__ __forceinline__ f32x2 gelu_pk(f32x2 v) {
    const f32x2 av = __builtin_elementwise_abs(v), d = av * 0.2316418882f + 1.0f;
    f32x2 t; t.x = __builtin_amdgcn_rcpf(d.x); t.y = __builtin_amdgcn_rcpf(d.y);
    f32x2 q = t * 0.5307027145f + (-0.7265760135f); q = q * t + 0.7107068705f; q = q * t + (-0.142248368f); q = q * t + 0.127414796f; q = q * t;
    const f32x2 s = (v * v) * (-0.72134752044f);
    f32x2 e; e.x = __builtin_amdgcn_exp2f(s.x); e.y = __builtin_amdgcn_exp2f(s.y);
    const f32x2 m = v * (q * e), r = v - m;
    f32x2 o; o.x = v.x < 0.f ? m.x : r.x; o.y = v.y < 0.f ? m.y : r.y; return o;
}
template <class Epi, class Sched, bool STAMP = false>
__device__ __forceinline__ void gemm_phase(PG8_LAS unsigned char* lds, const Gemm g, const Sched& S, const Epi& E, unsigned long long* stamps, const int wv) {
    int tid = wv * 64 + (int)__lane_id(); asm volatile("" : "+v"(tid)); const int wid = __builtin_amdgcn_readfirstlane(tid >> 6), lane = tid & 63, wr = wid >> 2, wc = wid & 3, fr = lane & 15, fq = lane >> 4;
    const int K = g.K, nt = K / BK;
    int ts_lo = 0, ts_hi = 0, nts = 0; const unsigned long long rt_entry = STAMP ? (unsigned long long)wall_clock64() : 0ull;
#define PG8_STAMP() do { if (STAMP && wid == 0 && nts < 64) { const unsigned long long _c = (unsigned long long)clock64(); \
        ts_lo = (lane == nts) ? (int)(unsigned)_c : ts_lo; ts_hi = (lane == nts) ? (int)(unsigned)(_c >> 32) : ts_hi; ++nts; } } while (0)
    PG8_STAMP();
    unsigned voffA[2], voffB[2];
#pragma unroll
    for (int i = 0; i < 2; ++i) { int R, C; stage_rc(tid * 16 + i * 8192, R, C); const int Rb = Epi::PERM ? ((R & ~31) + perm32(R & 31)) : R;
        voffA[i] = (unsigned)(R * K + C) * 2u; voffB[i] = (unsigned)(Rb * K + C) * 2u; }
    const size_t kstep = (size_t)(BK * 2);
    const size_t hstep = (size_t)HALF * K * 2;
    const size_t tstep = 2 * hstep;
    const unsigned ldsw = (unsigned)wid * 1024u;
    const int aoff = lds_byte(wr * 64 + fr, fq * 8), boff = lds_byte(wc * 32 + fr, fq * 8);
#define PG8_SA(b, h) (((b) * 2 + (h)) * HTB)
#define PG8_SB(b, h) ((4 + (b) * 2 + (h)) * HTB)
#define PG8_STAGE(bufoff, gbase, voff) do { _Pragma("unroll") for (int _i = 0; _i < 2; ++_i) \
        __builtin_amdgcn_global_load_lds((const unsigned*)((const char*)(gbase) + (voff)[_i]), (PG8_LAS unsigned*)(lds + (bufoff) + ldsw + _i * 8192), 16, 0, 0); } while (0)
#define PG8_LDA(dst, b, h) do { _Pragma("unroll") for (int m = 0; m < 4; ++m) _Pragma("unroll") for (int k = 0; k < 2; ++k) dst[m][k] = *(const PG8_LAS bf16x8*)(lds + PG8_SA(b, h) + aoff + m * 2048 + k * 1024); } while (0)
#define PG8_LDB(dst, b, h) do { _Pragma("unroll") for (int n = 0; n < 2; ++n) _Pragma("unroll") for (int k = 0; k < 2; ++k) dst[n][k] = *(const PG8_LAS bf16x8*)(lds + PG8_SB(b, h) + boff + n * 2048 + k * 1024); } while (0)
#define PG8_MMA(ai, bj, At, Bt) do { __builtin_amdgcn_s_setprio(1); _Pragma("unroll") for (int m = 0; m < 4; ++m) _Pragma("unroll") for (int n = 0; n < 2; ++n) _Pragma("unroll") for (int k = 0; k < 2; ++k) \
        acc[ai][bj][m][n] = __builtin_amdgcn_mfma_f32_16x16x32_bf16(Bt[n][k], At[m][k], acc[ai][bj][m][n], 0, 0, 0); __builtin_amdgcn_s_setprio(0); } while (0)
#define PG8_WAIT_V(n) asm volatile("s_waitcnt vmcnt(" #n ")" ::: "memory")
#define PG8_WAIT_L(n) asm volatile("s_waitcnt lgkmcnt(" #n ")" ::: "memory")
#define PG8_BAR __builtin_amdgcn_s_barrier()
#define PG8_SCHED __builtin_amdgcn_sched_barrier(0)
    Unit cur, nxt; int ui = 0;
    if (!S.next(0, cur)) return;
    f32x4 acc[2][2][4][2];
#pragma unroll
    for (int a = 0; a < 2; ++a)
#pragma unroll
        for (int b = 0; b < 2; ++b)
#pragma unroll
            for (int m = 0; m < 4; ++m)
#pragma unroll
                for (int n = 0; n < 2; ++n) acc[a][b][m][n] = (f32x4){0.f, 0.f, 0.f, 0.f};
    bf16x8 At[4][2], B0[2][2], B1[2][2];
    const char* cA = (const char*)g.A + (size_t)cur.pm * tstep; const char* cB = (const char*)g.Bt + (size_t)cur.pn * tstep;
    S.a_ready(cur);
    PG8_STAGE(PG8_SB(0, 0), cB, voffB); PG8_STAGE(PG8_SA(0, 0), cA, voffA); PG8_STAGE(PG8_SB(0, 1), cB + hstep, voffB); PG8_STAGE(PG8_SA(0, 1), cA + hstep, voffA);
    if (wr == 1) PG8_BAR;
    PG8_WAIT_V(4); PG8_BAR;
    PG8_STAGE(PG8_SB(1, 0), cB + kstep, voffB); PG8_STAGE(PG8_SA(1, 0), cA + kstep, voffA); PG8_STAGE(PG8_SB(1, 1), cB + hstep + kstep, voffB);
    PG8_WAIT_V(6); PG8_BAR;
    PG8_STAMP();
    for (;;) {
        const bool has_next = S.next(ui + 1, nxt);
        const char* nA = has_next ? (const char*)g.A + (size_t)nxt.pm * tstep : cA; const char* nB = has_next ? (const char*)g.Bt + (size_t)nxt.pn * tstep : cB;
        for (int t = 0; t < nt; t += 2) {
            const bool last = (t == nt - 2);
            const char* a1 = cA + (size_t)(t + 1) * kstep;
            const char* a2 = last ? nA : cA + (size_t)(t + 2) * kstep; const char* b2 = last ? nB : cB + (size_t)(t + 2) * kstep;
            const char* a3 = a2 + kstep; const char* b3 = b2 + kstep;
            if (last && has_next) S.a_ready(nxt);
            PG8_LDB(B0, 0, 0); PG8_SCHED; PG8_LDA(At, 0, 0); PG8_STAGE(PG8_SA(1, 1), a1 + hstep, voffA);
            PG8_WAIT_L(8); PG8_BAR; PG8_WAIT_L(0); PG8_MMA(0, 0, At, B0); PG8_BAR; PG8_SCHED;
            PG8_LDB(B1, 0, 1); PG8_STAGE(PG8_SB(0, 0), b2, voffB);
            PG8_BAR; PG8_WAIT_L(0); PG8_MMA(0, 1, At, B1); PG8_BAR;
            PG8_LDA(At, 0, 1); PG8_STAGE(PG8_SA(0, 0), a2, voffA);
            PG8_BAR; PG8_WAIT_L(0); PG8_MMA(1, 0, At, B0); PG8_BAR; PG8_SCHED;
            PG8_STAGE(PG8_SB(0, 1), b2 + hstep, voffB);
            PG8_WAIT_V(6); PG8_BAR; PG8_MMA(1, 1, At, B1); PG8_BAR;
            PG8_LDB(B0, 1, 0); PG8_SCHED; PG8_LDA(At, 1, 0); PG8_STAGE(PG8_SA(0, 1), a2 + hstep, voffA);
            PG8_WAIT_L(8); PG8_BAR; PG8_WAIT_L(0); PG8_MMA(0, 0, At, B0); PG8_BAR; PG8_SCHED;
            PG8_LDB(B1, 1, 1); PG8_STAGE(PG8_SB(1, 0), b3, voffB);
            PG8_BAR; PG8_WAIT_L(0); PG8_MMA(0, 1, At, B1); PG8_BAR;
            PG8_LDA(At, 1, 1); PG8_STAGE(PG8_SA(1, 0), a3, voffA);
            PG8_BAR; PG8_WAIT_L(0); PG8_MMA(1, 0, At, B0); PG8_BAR; PG8_SCHED;
            PG8_STAGE(PG8_SB(1, 1), b3 + hstep, voffB);
            PG8_WAIT_V(6); PG8_BAR; PG8_MMA(1, 1, At, B1); PG8_BAR;
        }
        PG8_STAMP();
        if constexpr (!Epi::AFTER_DRAIN) { E(acc, cur, wr, wc, fr, fq); S.done(cur); }
        PG8_STAMP();
        if (!has_next) break;
#pragma unroll
        for (int a = 0; a < 2; ++a)
#pragma unroll
            for (int b = 0; b < 2; ++b)
#pragma unroll
                for (int m = 0; m < 4; ++m)
#pragma unroll
                    for (int n = 0; n < 2; ++n) acc[a][b][m][n] = (f32x4){0.f, 0.f, 0.f, 0.f};
        cur = nxt; cA = nA; cB = nB; ++ui;
    }
    PG8_WAIT_V(0);
    if (wr == 0) PG8_BAR;
    PG8_BAR;
    if constexpr (Epi::AFTER_DRAIN) { E.fused(acc, cur, wr, wc, fr, fq, lds, wid, lane); S.done(cur); }
    PG8_STAMP();
    if (STAMP && wid == 0) { stamps[lane] = lane < nts ? (((unsigned long long)(unsigned)ts_hi << 32) | (unsigned)ts_lo) : 0ull;
        if (lane == 62) stamps[62] = rt_entry; if (lane == 63) stamps[63] = (unsigned long long)wall_clock64(); }
#undef PG8_STAMP
#undef PG8_SA
#undef PG8_SB
#undef PG8_STAGE
#undef PG8_LDA
#undef PG8_LDB
#undef PG8_MMA
#undef PG8_WAIT_V
#undef PG8_WAIT_L
#undef PG8_BAR
#undef PG8_SCHED
}
}

using pg8::bf16_t; using pg8::bf16x8; using pg8::f32x4; using pg8::u32x4; using pg8::Unit; using pg8::f32x2;
typedef unsigned short u16;
typedef float f32x16 __attribute__((ext_vector_type(16)));
typedef bf16x8 bf16x8_a4 __attribute__((aligned(4)));
typedef u32x4 u32x4_a4 __attribute__((aligned(4)));
typedef unsigned u32x2 __attribute__((ext_vector_type(2)));
#define DEVI __device__ __forceinline__
#define LAS __attribute__((address_space(3)))
#define LDS_WAIT() asm volatile("s_waitcnt lgkmcnt(0)" ::: "memory")
#define GAS __attribute__((address_space(1)))
DEVI unsigned char* launder_ws(unsigned char* p) { GAS unsigned char* g = (GAS unsigned char*)p; asm volatile("" : "+s"(g)); return (unsigned char*)g; }

#define XB_TMO      128
#define XB_XCNT(j)  (256  + 64 * (j))
#define XB_XSUB(j)  (1280 + 64 * (j))
#define XB_XGEN(j)  (2304 + 64 * (j))
#define XB_TOP      3328
#define XB_TOPGEN   3392
#define XCD_BAR_WORDS 3456
#define XB_SPIN_CAP (1u << 18)
__device__ __forceinline__ unsigned xb_ld(unsigned* p)              { return __hip_atomic_load(p, __ATOMIC_RELAXED, __HIP_MEMORY_SCOPE_AGENT); }
__device__ __forceinline__ unsigned xb_add(unsigned* p, unsigned v) { return __hip_atomic_fetch_add(p, v, __ATOMIC_RELAXED, __HIP_MEMORY_SCOPE_AGENT); }
__device__ __forceinline__ unsigned xb_xcc_id() { return (unsigned)__builtin_amdgcn_s_getreg((3 << 11) | 20) & 0xFu; }
#define XB_SPIN(cond, bar) do { unsigned _sp = 0; while (cond) { __builtin_amdgcn_s_sleep(1); \
    if ((++_sp & 255u) == 0u) { if (xb_ld(&(bar)[XB_TMO])) break; if (_sp > XB_SPIN_CAP) { atomicAdd(&(bar)[XB_TMO], 1u); break; } } } } while (0)

struct XcdBarrier {
    unsigned* bar; unsigned x;
    volatile LAS unsigned* st;
};

__device__ __forceinline__ XcdBarrier xcd_barrier_post(unsigned* bar, volatile LAS unsigned* st) {
    XcdBarrier b; b.bar = bar; b.x = xb_xcc_id(); b.st = st;
    if (threadIdx.x == 0) (void)xb_add(&bar[XB_XCNT(b.x)], 1u);
    return b;
}
__device__ __forceinline__ void xcd_barrier_complete(unsigned* bar, unsigned x, unsigned& nloc, unsigned& nx) {
    const unsigned G = gridDim.x * gridDim.y * gridDim.z;
    unsigned sum, cnt, mine, sp = 0u;
    for (;;) {
        sum = 0u; cnt = 0u; mine = 0u;
#pragma unroll
        for (unsigned j = 0; j < 16; ++j) { const unsigned c = xb_ld(&bar[XB_XCNT(j)]); sum += c; cnt += (c > 0u) ? 1u : 0u; mine = (j == x) ? c : mine; }
        if (sum == G) break;
        __builtin_amdgcn_s_sleep(1);
        if ((++sp & 255u) == 0u) { if (xb_ld(&bar[XB_TMO])) break; if (sp > XB_SPIN_CAP) { atomicAdd(&bar[XB_TMO], 1u); break; } }
    }
    nloc = mine > 0u ? mine : 1u; nx = cnt > 0u ? cnt : 1u;
}

__device__ __forceinline__ void xcd_barrier(const XcdBarrier& b, const bool leader) {
    asm volatile("s_waitcnt vmcnt(0)" ::: "memory");
    __syncthreads();
    if (leader) {
        unsigned* bar = b.bar;
        __builtin_amdgcn_s_waitcnt(0);
        unsigned nloc = b.st[0], nx = b.st[1];
        if (nloc == 0u) { xcd_barrier_complete(bar, b.x, nloc, nx); b.st[0] = nloc; b.st[1] = nx; }
        const unsigned old = xb_add(&bar[XB_XSUB(b.x)], 1u);
        const unsigned gen = old / nloc;
        if (old + 1u == (gen + 1u) * nloc) {
            __builtin_amdgcn_fence(__ATOMIC_RELEASE, "agent");
            asm volatile("s_waitcnt vmcnt(0)" ::: "memory");
            const unsigned og = xb_add(&bar[XB_TOP], 1u);
            const unsigned tg = og / nx;
            if (og + 1u == (tg + 1u) * nx) xb_add(&bar[XB_TOPGEN], 1u);
            else XB_SPIN(xb_ld(&bar[XB_TOPGEN]) == tg, bar);
            __builtin_amdgcn_fence(__ATOMIC_ACQUIRE, "agent");
            xb_add(&bar[XB_XGEN(b.x)], 1u);
            asm volatile("s_waitcnt vmcnt(0)" ::: "memory");
        } else {
            XB_SPIN(xb_ld(&bar[XB_XGEN(b.x)]) == gen, bar);
            __builtin_amdgcn_fence(__ATOMIC_ACQUIRE, "agent");
            asm volatile("s_waitcnt vmcnt(0)" ::: "memory");
        }
    }
    __syncthreads();
}

constexpr int T_ = 2048, MTOK = 65536;
constexpr float ALPHA_ = 1.41421356237f, LN_EPS_ = 1e-5f, GN_EPS_ = 64e-5f;
constexpr size_t MiB = 1u << 20;
constexpr size_t OFF_WINT = 1 * MiB, OFF_WOT = 15 * MiB, OFF_WUT = 19 * MiB, OFF_WDT = 41 * MiB, OFF_LT = 52 * MiB, OFF_MOD = 53 * MiB, OFF_GT = 55 * MiB,
                 OFF_A = 72 * MiB, OFF_B = 200 * MiB;
constexpr size_t OFF_PR = OFF_B, OFF_PH = OFF_B + 256 * MiB, OFF_UT = OFF_B + 448 * MiB, OFF_X0 = OFF_B + 512 * MiB, OFF_CONVT = OFF_B + 576 * MiB;
constexpr size_t OFF_EF = OFF_B + 256 * MiB, OFF_EB = OFF_B + 320 * MiB, OFF_AF = OFF_B + 384 * MiB, OFF_AB = OFF_B + 448 * MiB, OFF_G = OFF_B + 512 * MiB,
                 OFF_YF = OFF_B + 576 * MiB, OFF_YB = OFF_B + 640 * MiB;
constexpr size_t OFF_UA = OFF_B, OFF_UG = OFF_B + 352 * MiB;
constexpr size_t WS_NEED = OFF_B + 704 * MiB;
constexpr int GT_STRIDE = 4112;
constexpr int LT_PER_LAYER = 2 * 512 * 64 * 2 + 512 * 160;

struct Params { const float* in[36]; float* out; unsigned char* ws; };
enum { I_X = 0, I_C, I_WADA, I_BADA, I_ADAT, I_WIN, I_MUP, I_MUN, I_HCW, I_HCB, I_W0, I_WUP, I_A0, I_AUP, I_GUP, I_KK, I_KA, I_RK, I_GNW, I_GNB,
       I_FW1, I_FB1, I_FWIN, I_FBIN, I_FFREQ, I_FWOUT, I_HBIAS, I_WOUT, I_LMG, I_LMB, I_FUP, I_FCW, I_FCB, I_FDN, I_LFG, I_LFB };

DEVI u16 f2bf(float f) { unsigned u = __float_as_uint(f); u += 0x7FFFu + ((u >> 16) & 1u); return (u16)(u >> 16); }
DEVI float bf2f(unsigned b) { return __uint_as_float(b << 16); }
DEVI float bflo(unsigned w) { return __uint_as_float(w << 16); }
DEVI float bfhi(unsigned w) { return __uint_as_float(w & 0xFFFF0000u); }
DEVI unsigned pk2(float lo, float hi) { return pg8::cvt_pk_bf16(lo, hi); }
DEVI float wave_sum(float v) {
#pragma unroll
    for (int o = 1; o < 64; o <<= 1) v += __shfl_xor(v, o);
    return v;
}
DEVI float sum8(float v) { v += __shfl_xor(v, 1); v += __shfl_xor(v, 2); v += __shfl_xor(v, 4); return v; }
DEVI float sigmoidf_(float x) { return __builtin_amdgcn_rcpf(1.f + __expf(-x)); }
DEVI float tanhf_(float x) { return 1.f - 2.f * __builtin_amdgcn_rcpf(__expf(2.f * x) + 1.f); }
DEVI void unpack8(const u32x4 w, float (&o)[8]) { o[0] = bflo(w.x); o[1] = bfhi(w.x); o[2] = bflo(w.y); o[3] = bfhi(w.y); o[4] = bflo(w.z); o[5] = bfhi(w.z); o[6] = bflo(w.w); o[7] = bfhi(w.w); }
DEVI u32x4 pack8(const float (&v)[8]) { u32x4 w; w.x = pk2(v[0], v[1]); w.y = pk2(v[2], v[3]); w.z = pk2(v[4], v[5]); w.w = pk2(v[6], v[7]); return w; }
DEVI void load8f(const float* p, float (&o)[8]) { const f32x4 a = *(const f32x4*)p, b = *(const f32x4*)(p + 4); o[0] = a.x; o[1] = a.y; o[2] = a.z; o[3] = a.w; o[4] = b.x; o[5] = b.y; o[6] = b.z; o[7] = b.w; }

#define FMAC_DPP(acc_, d_, o_, N_) asm("v_fmac_f32_dpp %0, %1, %2 row_ror:" #N_ " row_mask:0xf bank_mask:0xf" : "+v"(acc_) : "v"(d_), "v"(o_))
#define MUL_DPP(dst_, d_, o_, N_) asm("v_mul_f32_dpp %0, %1, %2 row_ror:" #N_ " row_mask:0xf bank_mask:0xf" : "=v"(dst_) : "v"(d_), "v"(o_))
DEVI float red4(float x) {
    float a = x, b = x;
    asm volatile("s_nop 1\n\tv_permlane16_swap_b32 %0, %1" : "+v"(a), "+v"(b));
    const float s = a + b;
    a = s; b = s;
    asm volatile("s_nop 1\n\tv_permlane32_swap_b32 %0, %1" : "+v"(a), "+v"(b));
    return a + b;
}
DEVI float red8(float x) {
    float t;
    asm("s_nop 1\n\tv_add_f32_dpp %0, %1, %1 quad_perm:[1,0,3,2] row_mask:0xf bank_mask:0xf" : "=v"(t) : "v"(x)); x = t;
    asm("s_nop 1\n\tv_add_f32_dpp %0, %1, %1 quad_perm:[2,3,0,1] row_mask:0xf bank_mask:0xf" : "=v"(t) : "v"(x)); x = t;
    asm("s_nop 1\n\tv_add_f32_dpp %0, %1, %1 row_half_mirror row_mask:0xf bank_mask:0xf" : "=v"(t) : "v"(x));
    return t;
}
DEVI void red8x2(float& x0, float& x1) {
    asm volatile("s_nop 1\n\t"
                 "v_add_f32_dpp %0, %0, %0 quad_perm:[1,0,3,2] row_mask:0xf bank_mask:0xf\n\t"
                 "v_add_f32_dpp %1, %1, %1 quad_perm:[1,0,3,2] row_mask:0xf bank_mask:0xf\n\t"
                 "s_nop 0\n\t"
                 "v_add_f32_dpp %0, %0, %0 quad_perm:[2,3,0,1] row_mask:0xf bank_mask:0xf\n\t"
                 "v_add_f32_dpp %1, %1, %1 quad_perm:[2,3,0,1] row_mask:0xf bank_mask:0xf\n\t"
                 "s_nop 0\n\t"
                 "v_add_f32_dpp %0, %0, %0 row_half_mirror row_mask:0xf bank_mask:0xf\n\t"
                 "v_add_f32_dpp %1, %1, %1 row_half_mirror row_mask:0xf bank_mask:0xf"
                 : "+v"(x0), "+v"(x1));
}
DEVI float wave_sum_dpp(float x) {
    float t;
    asm("s_nop 1\n\tv_add_f32_dpp %0, %1, %1 row_ror:1 row_mask:0xf bank_mask:0xf" : "=v"(t) : "v"(x)); x = t;
    asm("s_nop 1\n\tv_add_f32_dpp %0, %1, %1 row_ror:2 row_mask:0xf bank_mask:0xf" : "=v"(t) : "v"(x)); x = t;
    asm("s_nop 1\n\tv_add_f32_dpp %0, %1, %1 row_ror:4 row_mask:0xf bank_mask:0xf" : "=v"(t) : "v"(x)); x = t;
    asm("s_nop 1\n\tv_add_f32_dpp %0, %1, %1 row_ror:8 row_mask:0xf bank_mask:0xf" : "=v"(t) : "v"(x)); x = t;
    return red4(x);
}

struct EpiSplitBf16 {
    static constexpr bool PERM = true, AFTER_DRAIN = false;
    u16* O0; u16* O1; int nsplit, ld0, ld1;
    __device__ __forceinline__ void operator()(const f32x4 (&acc)[2][2][4][2], const Unit& u, int wr, int wc, int fr, int fq) const {
        const int row0 = u.pm * 256 + wr * 64 + fr;
        u16* base; int ldc, colt;
        if (u.pn < nsplit) { base = O0; ldc = ld0; colt = u.pn * 256; } else { base = O1; ldc = ld1; colt = (u.pn - nsplit) * 256; }
        const int col0 = colt + wc * 32 + 8 * fq;
#pragma unroll
        for (int ai = 0; ai < 2; ++ai)
#pragma unroll
            for (int m = 0; m < 4; ++m) { u16* rowp = base + (size_t)(row0 + ai * 128 + m * 16) * ldc + col0;
#pragma unroll
                for (int bj = 0; bj < 2; ++bj) { const f32x4 v0 = acc[ai][bj][m][0], v1 = acc[ai][bj][m][1];
                    u32x4 w; w.x = pk2(v0[0], v0[1]); w.y = pk2(v0[2], v0[3]); w.z = pk2(v1[0], v1[1]); w.w = pk2(v1[2], v1[3]);
                    *(u32x4*)(rowp + bj * 128) = w; } }
    }
};
struct EpiRes {
    static constexpr bool PERM = false, AFTER_DRAIN = false;
    const float* xin; float* xout; const float* gate;
    __device__ __forceinline__ void operator()(const f32x4 (&acc)[2][2][4][2], const Unit& u, int wr, int wc, int fr, int fq) const {
        const int row0 = u.pm * 256 + wr * 64 + fr, col0 = u.pn * 256 + wc * 32 + 4 * fq;
        const float* gp = gate + (size_t)(u.pm >> 3) * 6144 + col0;
        f32x4 gv[2][2];
#pragma unroll
        for (int bj = 0; bj < 2; ++bj)
#pragma unroll
            for (int n = 0; n < 2; ++n) gv[bj][n] = *(const f32x4*)(gp + bj * 128 + n * 16) + 1.0f;
#pragma unroll
        for (int ai = 0; ai < 2; ++ai)
#pragma unroll
            for (int m = 0; m < 4; ++m) { const size_t off = (size_t)(row0 + ai * 128 + m * 16) * 1024 + col0;
#pragma unroll
                for (int bj = 0; bj < 2; ++bj)
#pragma unroll
                    for (int n = 0; n < 2; ++n) { const f32x4 xv = *(const f32x4*)(xin + off + bj * 128 + n * 16);
                        *(f32x4*)(xout + off + bj * 128 + n * 16) = xv * ALPHA_ + gv[bj][n] * acc[ai][bj][m][n]; } }
    }
};

template <class Epi> DEVI void run_gemm(LAS unsigned char* lds, const u16* A, const u16* Bt, int N, int K, const Epi& E, int wv) {
    pg8::Gemm g; g.A = A; g.Bt = Bt; g.M = MTOK; g.N = N; g.K = K;
    pg8::StaticOrder S; S.init(MTOK, N, (int)gridDim.x, (int)blockIdx.x);
    pg8::gemm_phase<Epi, pg8::StaticOrder, false>(lds, g, S, E, nullptr, wv);
}

DEVI void transpose_item(const float* W, int K, int N, u16* WT, int drow, LAS float* scr, int k0, int n0, int lane) {
#pragma unroll 8
    for (int i = 0; i < 32; ++i) { const int kk = 2 * i + (lane >> 5); scr[kk * 33 + (lane & 31)] = W[(size_t)(k0 + kk) * N + n0 + (lane & 31)]; }
    LDS_WAIT();
    const int c = lane & 7;
#pragma unroll
    for (int j = 0; j < 4; ++j) { const int n = (lane >> 3) + 8 * j; const LAS float* s = scr + (8 * c) * 33 + n;
        u32x4 o; o.x = pk2(s[0 * 33], s[1 * 33]); o.y = pk2(s[2 * 33], s[3 * 33]); o.z = pk2(s[4 * 33], s[5 * 33]); o.w = pk2(s[6 * 33], s[7 * 33]);
        *(u32x4*)(WT + (size_t)(drow + n) * K + k0 + 8 * c) = o; }
    LDS_WAIT();
}

DEVI void phase_prologue(const Params& P, LAS unsigned char* lds, int wv) {
    int tid_l = wv * 64 + (int)__lane_id(); asm volatile("" : "+v"(tid_l));
    const int tid = tid_l, lane = tid & 63, wave = tid >> 6;
    unsigned char* ws = launder_ws(P.ws);
    float* MOD = (float*)(ws + OFF_MOD);
#if defined(PROBE_VALU)
    {
        float a[16]; float z = (float)tid * 1e-3f;
#pragma unroll
        for (int i = 0; i < 16; ++i) a[i] = (float)(tid + i) * 1e-4f;
        for (int it = 0; it < PROBE_N; ++it) {
#if PROBE_VALU == 1
            FMAC_DPP(a[1], z, a[0], 1); FMAC_DPP(a[2], z, a[0], 2); FMAC_DPP(a[3], z, a[0], 3); FMAC_DPP(a[4], z, a[0], 4); FMAC_DPP(a[5], z, a[0], 5);
            FMAC_DPP(a[6], z, a[0], 6); FMAC_DPP(a[7], z, a[0], 7); FMAC_DPP(a[8], z, a[0], 8); FMAC_DPP(a[9], z, a[0], 9); FMAC_DPP(a[10], z, a[0], 10);
            FMAC_DPP(a[11], z, a[0], 11); FMAC_DPP(a[12], z, a[0], 12); FMAC_DPP(a[13], z, a[0], 13); FMAC_DPP(a[14], z, a[0], 14); FMAC_DPP(a[15], z, a[0], 15);
#else
#pragma unroll
            for (int i = 1; i < 16; ++i) asm volatile("v_fmac_f32_e32 %0, %1, %2" : "+v"(a[i]) : "v"(z), "v"(a[0]));
#endif
            asm volatile("" : "+v"(a[0]));
        }
        float sum = 0.f;
#pragma unroll
        for (int i = 0; i < 16; ++i) sum += a[i];
        if (sum == 123.456f) MOD[0] = sum;
    }
#endif
    {
        LAS float* red = (LAS float*)lds;
        const float* cin = P.in[I_C]; const float* W = P.in[I_WADA];
        const int r = lane & 31, hh = lane >> 5;
        for (int item = blockIdx.x; item < 192; item += gridDim.x) {
            const int n0 = item * 32;
            f32x16 acc;
#pragma unroll
            for (int i = 0; i < 16; ++i) acc[i] = 0.f;
#pragma unroll 16
            for (int ks = 0; ks < 64; ++ks) {
                const int k = wave * 128 + ks * 2 + hh;
                const float cv = cin[r * 1024 + k]; const float a = cv / (1.f + expf(-cv));
                const float bv = W[(size_t)k * 6144 + n0 + r];
                acc = __builtin_amdgcn_mfma_f32_32x32x2f32(a, bv, acc, 0, 0, 0);
            }
#pragma unroll
            for (int rg = 0; rg < 16; ++rg) { const int row = (rg & 3) + 8 * (rg >> 2) + 4 * hh; red[(wave * 32 + row) * 32 + r] = acc[rg]; }
            __syncthreads();
            for (int e = tid; e < 1024; e += 512) {
                const int row = e >> 5, col = e & 31; float s = 0.f;
#pragma unroll
                for (int w = 0; w < 8; ++w) s += red[(w * 32 + row) * 32 + col];
                const int n = n0 + col; s += P.in[I_BADA][n];
                const int gi = n >> 10, nn = n & 1023;
#pragma unroll
                for (int l = 0; l < 2; ++l) MOD[((size_t)(l * 32 + row) * 6 + gi) * 1024 + nn] = s + P.in[I_ADAT][(l * 6 + gi) * 1024 + nn];
            }
            __syncthreads();
        }
    }
    {
        LAS float* scr = (LAS float*)(lds + 32768) + wave * (64 * 33);
        const int gw = blockIdx.x * 8 + wave, NGW = gridDim.x * 8;
        u16* WINT = (u16*)(ws + OFF_WINT); u16* WOT = (u16*)(ws + OFF_WOT); u16* WUT = (u16*)(ws + OFF_WUT); u16* WDT = (u16*)(ws + OFF_WDT);
        for (int it = gw; it < 2 * 6480; it += NGW) {
            const int l = it / 6480; int r = it % 6480;
            if (r < 1744) { const int kb = r / 109, nb = r % 109, n0 = nb * 32, drow = n0 < 1952 ? n0 : n0 + 96;
                transpose_item(P.in[I_WIN] + (size_t)l * 1024 * 3488, 1024, 3488, WINT + (size_t)l * 3584 * 1024, drow, scr, kb * 64, n0, lane); continue; }
            r -= 1744;
            if (r < 512) { const int kb = r / 32, nb = r % 32;
                transpose_item(P.in[I_WOUT] + (size_t)l * 1024 * 1024, 1024, 1024, WOT + (size_t)l * 1024 * 1024, nb * 32, scr, kb * 64, nb * 32, lane); continue; }
            r -= 512;
            if (r < 2816) { const int kb = r / 176, nb = r % 176;
                transpose_item(P.in[I_FUP] + (size_t)l * 1024 * 5632, 1024, 5632, WUT + (size_t)l * 5632 * 1024, nb * 32, scr, kb * 64, nb * 32, lane); continue; }
            r -= 2816;
            { const int kb = r / 32, nb = r % 32;
                transpose_item(P.in[I_FDN] + (size_t)l * 2816 * 1024, 2816, 1024, WDT + (size_t)l * 1024 * 2816, nb * 32, scr, kb * 64, nb * 32, lane); }
        }
        const int gtid = blockIdx.x * 512 + tid, NT = gridDim.x * 512;
        for (int i = gtid; i < 2 * 96 * 128; i += NT) { const int l = i / (96 * 128), rr = i % (96 * 128);
            *(u32x4*)(WINT + (size_t)l * 3584 * 1024 + (size_t)1952 * 1024 + (size_t)rr * 8) = (u32x4){0u, 0u, 0u, 0u}; }
        u16* LT = (u16*)(ws + OFF_LT);
        for (int i = gtid; i < 2 * LT_PER_LAYER; i += NT) {
            const int l = i / LT_PER_LAYER; int e = i % LT_PER_LAYER; float v;
            if (e < 65536) { const int d = e >> 15, n = (e >> 6) & 511, k = e & 63; v = P.in[I_WUP][((size_t)(l * 2 + d) * 64 + k) * 512 + n]; }
            else if (e < 131072) { const int e2 = e - 65536; const int d = e2 >> 15, n = (e2 >> 6) & 511, k = e2 & 63; v = P.in[I_AUP][((size_t)(l * 2 + d) * 64 + k) * 512 + n]; }
            else { const int e2 = e - 131072; const int n = e2 / 160, k = e2 % 160; v = P.in[I_GUP][((size_t)l * 160 + k) * 512 + n]; }
            LT[i] = f2bf(e < 131072 ? v * -1.44269504089f : v);
        }
    }
    __syncthreads();
    {
        LAS float* zb = (LAS float*)lds;
        LAS float* hb0 = zb + 8 * 36;
        LAS float* hb1 = hb0 + 64 * 8;
        u16* GT = (u16*)(ws + OFF_GT);
        const int p = tid >> 6, j = tid & 63;
        for (int item = blockIdx.x; item < 512; item += gridDim.x) {
            const int l = item >> 8, i0 = (item & 255) * 8, i = i0 + p;
            const float t = (float)i * (1.0f / 2047.0f);
            if (j < 33) {
                float z;
                if (j == 0) z = t;
                else { const int bnd = (j - 1) & 15; const float f = 1e-4f + (float)bnd * ((15.0f - 1e-4f) / 15.0f);
                    const float ang = (6.283185307179586f / 2048.0f) * (float)i * f; z = (j <= 16) ? cosf(ang) : -sinf(ang); }
                zb[p * 36 + j] = z;
            }
            __syncthreads();
            const float fr = P.in[I_FFREQ][l * 64 + j];
            { float a = P.in[I_FB1][l * 64 + j]; const float* w1 = P.in[I_FW1] + (size_t)l * 33 * 64 + j;
#pragma unroll 11
                for (int m = 0; m < 33; ++m) a += zb[p * 36 + m] * w1[m * 64];
                hb0[j * 8 + p] = sinf(fr * a); }
            __syncthreads();
            { float a = P.in[I_FBIN][(l * 2 + 0) * 64 + j]; const float* w = P.in[I_FWIN] + (size_t)(l * 2 + 0) * 4096 + j;
#pragma unroll 16
                for (int m = 0; m < 64; ++m) a += hb0[m * 8 + p] * w[m * 64];
                hb1[j * 8 + p] = sinf(fr * a); }
            __syncthreads();
            { float a = P.in[I_FBIN][(l * 2 + 1) * 64 + j]; const float* w = P.in[I_FWIN] + (size_t)(l * 2 + 1) * 4096 + j;
#pragma unroll 16
                for (int m = 0; m < 64; ++m) a += hb1[m * 8 + p] * w[m * 64];
                a = sinf(fr * a);
                __syncthreads();
                hb0[j * 8 + p] = a; }
            __syncthreads();
#pragma unroll
            for (int qq = 0; qq < 2; ++qq) {
                const int n = j + 64 * (p + 8 * qq);
                float acc8[8];
#pragma unroll
                for (int pp = 0; pp < 8; ++pp) acc8[pp] = 0.f;
                const float* wo = P.in[I_FWOUT] + (size_t)l * 64 * 1024 + n;
#pragma unroll 16
                for (int m = 0; m < 64; ++m) { const float w = wo[m * 1024]; const f32x4 h0 = *(const LAS f32x4*)(hb0 + m * 8), h1 = *(const LAS f32x4*)(hb0 + m * 8 + 4);
                    acc8[0] += h0.x * w; acc8[1] += h0.y * w; acc8[2] += h0.z * w; acc8[3] += h0.w * w; acc8[4] += h1.x * w; acc8[5] += h1.y * w; acc8[6] += h1.z * w; acc8[7] += h1.w * w; }
                const int c = n & 511;
                const float dl = fabsf(-3.0701134573f + (float)c * ((-15.3505672866f + 3.0701134573f) / 511.0f));
                u16* g0 = GT + ((size_t)(l * 512 + c) * 2) * GT_STRIDE; u16* g1 = g0 + GT_STRIDE;
#pragma unroll
                for (int pp = 0; pp < 8; ++pp) {
                    const int ii = i0 + pp; const float tt = (float)ii * (1.0f / 2047.0f);
                    float val = acc8[pp] * expf(-tt * dl);
                    int idx;
                    if (n < 512) { idx = 2048 - ii; if (ii == 0) val += P.in[I_HBIAS][l * 512 + c]; } else { idx = 2048 + ii; }
                    if (n < 512 || ii > 0) { const u16 hv = f2bf(val); g0[idx] = hv; g1[idx - 1] = hv; }
                }
            }
            __syncthreads();
        }
    }
}

template <int MODE> DEVI void phase_ln(const float* xin, const u16* mix, const float* gate, float* dst, const float* g, const float* bta, const float* modsh, const float* modsc, u16* H, int wv) {
    int tid_l = wv * 64 + (int)__lane_id(); asm volatile("" : "+v"(tid_l));
    const int lane = tid_l & 63, wave = tid_l >> 6;
    const int gw = blockIdx.x * 8 + wave, NGW = gridDim.x * 8;
    constexpr int R = 8;
    for (int row0 = gw * R; row0 < MTOK; row0 += NGW * R) {
        const int b = row0 >> 11;
        f32x4 v[R][4]; float s[R], s2[R], mean[R], rstd[R];
#pragma unroll
        for (int r = 0; r < R; ++r) { const f32x4* xr = (const f32x4*)(xin + (size_t)(row0 + r) * 1024) + lane;
#pragma unroll
            for (int j = 0; j < 4; ++j) v[r][j] = __builtin_nontemporal_load(xr + 64 * j); }
        if (MODE >= 1) {
            u32x2 mr[R][4];
#pragma unroll
            for (int r = 0; r < R; ++r) { const u32x2* mp = (const u32x2*)(mix + (size_t)(row0 + r) * 1024) + lane;
#pragma unroll
                for (int j = 0; j < 4; ++j) mr[r][j] = __builtin_nontemporal_load(mp + 64 * j); }
            const f32x4* gp = (const f32x4*)(gate + (size_t)b * 6144) + lane;
#pragma unroll
            for (int j = 0; j < 4; ++j) { const f32x4 gv = gp[64 * j] + 1.0f;
#pragma unroll
                for (int r = 0; r < R; ++r) { const f32x4 mv = (f32x4){bflo(mr[r][j].x), bfhi(mr[r][j].x), bflo(mr[r][j].y), bfhi(mr[r][j].y)};
                    v[r][j] = v[r][j] * ALPHA_ + gv * mv; } }
        }
#pragma unroll
        for (int r = 0; r < R; ++r) { s[r] = 0.f;
#pragma unroll
            for (int j = 0; j < 4; ++j) s[r] += (v[r][j].x + v[r][j].y) + (v[r][j].z + v[r][j].w); }
#pragma unroll
        for (int r = 0; r < R; ++r) mean[r] = wave_sum_dpp(s[r]) * (1.f / 1024.f);
#pragma unroll
        for (int r = 0; r < R; ++r) { s2[r] = 0.f;
#pragma unroll
            for (int j = 0; j < 4; ++j) { v[r][j] = v[r][j] - mean[r]; s2[r] += (v[r][j].x * v[r][j].x + v[r][j].y * v[r][j].y) + (v[r][j].z * v[r][j].z + v[r][j].w * v[r][j].w); } }
#pragma unroll
        for (int r = 0; r < R; ++r) rstd[r] = 1.f / sqrtf(wave_sum_dpp(s2[r]) * (1.f / 1024.f) + LN_EPS_);
        if (MODE >= 1) {
#pragma unroll
            for (int j = 0; j < 4; ++j) { const f32x4 gg = *((const f32x4*)g + lane + 64 * j), bb = *((const f32x4*)bta + lane + 64 * j);
#pragma unroll
                for (int r = 0; r < R; ++r) { v[r][j] = v[r][j] * rstd[r] * gg + bb; __builtin_nontemporal_store(v[r][j], (f32x4*)(dst + (size_t)(row0 + r) * 1024) + lane + 64 * j); } }
            if (MODE == 1) {
#pragma unroll
                for (int r = 0; r < R; ++r) { s[r] = 0.f;
#pragma unroll
                    for (int j = 0; j < 4; ++j) s[r] += (v[r][j].x + v[r][j].y) + (v[r][j].z + v[r][j].w); }
#pragma unroll
                for (int r = 0; r < R; ++r) mean[r] = wave_sum_dpp(s[r]) * (1.f / 1024.f);
#pragma unroll
                for (int r = 0; r < R; ++r) { s2[r] = 0.f;
#pragma unroll
                    for (int j = 0; j < 4; ++j) { v[r][j] = v[r][j] - mean[r]; s2[r] += (v[r][j].x * v[r][j].x + v[r][j].y * v[r][j].y) + (v[r][j].z * v[r][j].z + v[r][j].w * v[r][j].w); } }
#pragma unroll
                for (int r = 0; r < R; ++r) rstd[r] = 1.f / sqrtf(wave_sum_dpp(s2[r]) * (1.f / 1024.f) + LN_EPS_);
            }
        }
        if (MODE <= 1) {
            const f32x4* sh = (const f32x4*)(modsh + (size_t)b * 6144) + lane; const f32x4* sc = (const f32x4*)(modsc + (size_t)b * 6144) + lane;
#pragma unroll
            for (int j = 0; j < 4; ++j) { const f32x4 scv = sc[64 * j] + 1.0f, shv = sh[64 * j];
#pragma unroll
                for (int r = 0; r < R; ++r) { const f32x4 y = v[r][j] * rstd[r] * scv + shv;
                    __builtin_nontemporal_store((unsigned long long)pk2(y.x, y.y) | ((unsigned long long)pk2(y.z, y.w) << 32), (unsigned long long*)(H + (size_t)(row0 + r) * 1024) + lane + 64 * j); } }
        }
    }
}

DEVI void phase_hy_prep(const Params& P, int l, LAS unsigned char* lds, int wv) {
    int tid_l = wv * 64 + (int)__lane_id(); asm volatile("" : "+v"(tid_l));
    unsigned char* ws = launder_ws(P.ws); asm volatile("" : "+s"(l));
    const u16* PH = (const u16*)(ws + OFF_PH); u16* UT = (u16*)(ws + OFF_UT); u16* X0 = (u16*)(ws + OFF_X0);
    const int tsub = tid_l >> 6, c8 = (tid_l & 63) * 8;
    for (int item = blockIdx.x; item < 1024; item += gridDim.x) {
        const int b = item >> 5, t0 = (item & 31) * 64 + tsub * 8;
        const u16* base = PH + ((size_t)b * T_ + t0) * 1536 + c8;
        const bool hp = t0 > 0, hn = (t0 + 8) < T_;
        float u[8][8];
#pragma unroll
        for (int i = 0; i < 3; ++i) {
            float w0[8], w1[8], w2[8], bs[8];
            load8f(P.in[I_HCW] + ((size_t)l * 3 + 0) * 1536 + i * 512 + c8, w0); load8f(P.in[I_HCW] + ((size_t)l * 3 + 1) * 1536 + i * 512 + c8, w1);
            load8f(P.in[I_HCW] + ((size_t)l * 3 + 2) * 1536 + i * 512 + c8, w2); load8f(P.in[I_HCB] + (size_t)l * 1536 + i * 512 + c8, bs);
            u32x4 raw[10];
            raw[0] = *(const u32x4*)(hp ? base - 1536 + i * 512 : base + i * 512);
#pragma unroll
            for (int r = 0; r < 8; ++r) raw[r + 1] = *(const u32x4*)(base + (size_t)r * 1536 + i * 512);
            raw[9] = *(const u32x4*)(hn ? base + (size_t)8 * 1536 + i * 512 : base + i * 512);
            float prev[8], cur[8], nxt[8];
            unpack8(raw[0], prev); unpack8(raw[1], cur);
            if (!hp) {
#pragma unroll
                for (int j = 0; j < 8; ++j) prev[j] = 0.f; }
#pragma unroll
            for (int r = 0; r < 8; ++r) {
                unpack8(raw[r + 2], nxt);
                if (r == 7 && !hn) {
#pragma unroll
                    for (int j = 0; j < 8; ++j) nxt[j] = 0.f; }
                float q[8];
#pragma unroll
                for (int j = 0; j < 8; ++j) { q[j] = w0[j] * prev[j] + w1[j] * cur[j] + w2[j] * nxt[j] + bs[j]; prev[j] = cur[j]; cur[j] = nxt[j]; }
                if (i == 0) *(u32x4*)(X0 + ((size_t)b * T_ + t0 + r) * 512 + c8) = pack8(q);
                else if (i == 1) {
#pragma unroll
                    for (int j = 0; j < 8; ++j) u[r][j] = q[j]; }
                else {
#pragma unroll
                    for (int j = 0; j < 8; ++j) u[r][j] *= q[j]; }
            }
        }
#pragma unroll
        for (int j = 0; j < 8; ++j) { const float col[8] = {u[0][j], u[1][j], u[2][j], u[3][j], u[4][j], u[5][j], u[6][j], u[7][j]};
            *(u32x4*)(UT + ((size_t)(c8 + j) * 32 + b) * T_ + t0) = pack8(col); }
    }
}

DEVI void phase_hy_conv(const Params& P, int l, int wv) {
    int tid_l = wv * 64 + (int)__lane_id(); asm volatile("" : "+v"(tid_l));
    unsigned char* ws = launder_ws(P.ws); asm volatile("" : "+s"(l));
    const int lane = tid_l & 63, wave = __builtin_amdgcn_readfirstlane(tid_l >> 6), r = lane & 31, hh = lane >> 5;
    const u16* GT = (const u16*)(ws + OFF_GT); const u16* UT = (const u16*)(ws + OFF_UT); u16* CONVT = (u16*)(ws + OFF_CONVT);
    const int lanebase = 2048 + 8 * hh - r - 256 * wave;
    const int par = lanebase & 1;
    const unsigned goff = (unsigned)((par * GT_STRIDE + lanebase - par) * 2);
    const unsigned uoff = (unsigned)((r * T_ + 8 * hh) * 2), soff = (unsigned)((r * T_ + 4 * hh) * 2);
    for (int c = blockIdx.x; c < 512; c += gridDim.x) {
        const char* gts = (const char*)(GT + ((size_t)(l * 512 + c) * 2) * GT_STRIDE) - 512;
        const char* utb = (const char*)(UT + (size_t)c * 32 * T_);
        f32x16 acc[8];
#pragma unroll
        for (int m = 0; m < 8; ++m)
#pragma unroll
            for (int i = 0; i < 16; ++i) acc[m][i] = 0.f;
        bf16x8 W[16];
#define HY_LOADF(gb_, e16_) (*(const bf16x8_a4*)((gb_) + goff + 32 * (e16_)))
#define HY_LOADB(ub_, j_) (*(const bf16x8*)((ub_) + uoff + 32 * (j_)))
#pragma unroll
        for (int u = 0; u < 16; ++u) W[u] = (bf16x8){0, 0, 0, 0, 0, 0, 0, 0};
#pragma unroll
        for (int u = 2; u < 16; ++u) W[u] = HY_LOADF(gts, u);
        bf16x8 wn0 = HY_LOADF(gts, 16), wn1 = HY_LOADF(gts, 17);
        bf16x8 bn0 = HY_LOADB(utb, 0), bn1 = HY_LOADB(utb, 1);
        for (int jj = 0; jj < 8; ++jj) {
            const char* gj = gts + 512 * jj; const char* uj = utb + 512 * jj;
#pragma unroll
            for (int u = 0; u < 16; ++u) {
                bf16x8 bfr;
                if ((u & 1) == 0) { W[u] = wn0; bfr = bn0; wn0 = HY_LOADF(gj, u + 18); bn0 = HY_LOADB(uj, u + 2); }
                else { W[u] = wn1; bfr = bn1; wn1 = HY_LOADF(gj, u + 18); bn1 = HY_LOADB(uj, u + 2); }
#pragma unroll
                for (int m = 0; m < 8; ++m) acc[m] = __builtin_amdgcn_mfma_f32_32x32x16_bf16(W[(u - 2 * m) & 15], bfr, acc[m], 0, 0, 0);
            }
        }
#undef HY_LOADF
#undef HY_LOADB
        char* cb = (char*)(CONVT + (size_t)c * 32 * T_) + 512 * wave;
#pragma unroll
        for (int m = 0; m < 8; ++m) {
#pragma unroll
            for (int q = 0; q < 4; ++q) { u32x2 o; o.x = pk2(acc[m][4 * q], acc[m][4 * q + 1]); o.y = pk2(acc[m][4 * q + 2], acc[m][4 * q + 3]);
                *(u32x2*)(cb + soff + (64 * m + 16 * q)) = o; } }
    }
}

DEVI void phase_hy_post(const Params& P, LAS unsigned char* lds, int wv) {
    int tid_l = wv * 64 + (int)__lane_id(); asm volatile("" : "+v"(tid_l));
    unsigned char* ws = launder_ws(P.ws);
    const u16* CONVT = (const u16*)(ws + OFF_CONVT); const u16* X0 = (const u16*)(ws + OFF_X0); u16* YM = (u16*)(ws + OFF_A);
    const int tsub = tid_l >> 6, c8 = (tid_l & 63) * 8;
    for (int item = blockIdx.x; item < 1024; item += gridDim.x) {
        const int b = item >> 5, t0 = (item & 31) * 64 + tsub * 8;
        u32x4 cv[8], xv[8];
#pragma unroll
        for (int j = 0; j < 8; ++j) cv[j] = *(const u32x4*)(CONVT + ((size_t)(c8 + j) * 32 + b) * T_ + t0);
#pragma unroll
        for (int r = 0; r < 8; ++r) xv[r] = *(const u32x4*)(X0 + ((size_t)b * T_ + t0 + r) * 512 + c8);
        float cf[8][8];
#pragma unroll
        for (int j = 0; j < 8; ++j) unpack8(cv[j], cf[j]);
#pragma unroll
        for (int r = 0; r < 8; ++r) { float x[8], o[8]; unpack8(xv[r], x);
#pragma unroll
            for (int j = 0; j < 8; ++j) o[j] = x[j] * cf[j][r];
            *(u32x4*)(YM + ((size_t)b * T_ + t0 + r) * 1024 + 512 + c8) = pack8(o); }
    }
}

DEVI void phase_rwkv_prep(const Params& P, int l, int wv) {
    int tid_l = wv * 64 + (int)__lane_id(); asm volatile("" : "+v"(tid_l));
    unsigned char* ws = launder_ws(P.ws); asm volatile("" : "+s"(l));
    const int lane = tid_l & 63, wave = tid_l >> 6, r = lane & 31, hh = lane >> 5;
    const int gw = blockIdx.x * 8 + wave, NGW = gridDim.x * 8;
    const u16* PR = (const u16*)(ws + OFF_PR);
    const u16* LT = (const u16*)(ws + OFF_LT) + (size_t)l * LT_PER_LAYER;
    const float* mup = P.in[I_MUP] + l * 1952; const float* mun = P.in[I_MUN] + l * 1952;
    for (int it = gw; it < 2048 * 5; it += NGW) {
        const int mat = it % 5, tok0 = (it / 5) * 32, tok = tok0 + r, t = tok & 2047;
        const int K = (mat == 4) ? 160 : 64, cbase = (mat == 4) ? 1792 : 1536 + 64 * mat;
        const u16* pr = PR + (size_t)tok * 2048 + cbase + 8 * hh;
        bf16x8 af[10];
#pragma unroll
        for (int kk = 0; kk < 10; ++kk) {
            af[kk] = (bf16x8){0, 0, 0, 0, 0, 0, 0, 0};
            if (kk * 16 < K) {
                float pc[8], pp[8], pn[8], mp[8], mn[8], x[8];
                unpack8(*(const u32x4*)(pr + kk * 16), pc);
                if (t > 0) unpack8(*(const u32x4*)(pr + kk * 16 - 2048), pp); else {
#pragma unroll
                    for (int q = 0; q < 8; ++q) pp[q] = 0.f; }
                if (t < T_ - 1) unpack8(*(const u32x4*)(pr + kk * 16 + 2048), pn); else {
#pragma unroll
                    for (int q = 0; q < 8; ++q) pn[q] = 0.f; }
                load8f(mup + cbase + 8 * hh + kk * 16, mp); load8f(mun + cbase + 8 * hh + kk * 16, mn);
#pragma unroll
                for (int q = 0; q < 8; ++q) { float v = pc[q] + mp[q] * (pp[q] - pc[q]) + mn[q] * (pn[q] - pc[q]);
                    if (mat < 2) v = tanhf_(v); else if (mat == 4) v = sigmoidf_(v);
                    x[q] = v; }
                const u32x4 pk = pack8(x);
                af[kk] = __builtin_bit_cast(bf16x8, pk);
            }
        }
        const u16* lt = (mat < 2) ? LT + (size_t)mat * 32768 : (mat < 4) ? LT + 65536 + (size_t)(mat - 2) * 32768 : LT + 131072;
        const float* bias = (mat < 2) ? P.in[I_W0] + (size_t)(l * 2 + mat) * 512 : P.in[I_A0] + (size_t)(l * 2 + (mat & 1)) * 512;
        u16* outp = (u16*)(ws + (mat == 0 ? OFF_EF : mat == 1 ? OFF_EB : mat == 2 ? OFF_AF : mat == 3 ? OFF_AB : OFF_G));
#define GLOAD16(dst_, ptr_) asm volatile("global_load_dwordx4 %0, %1, off" : "=v"(dst_) : "v"(ptr_) : "memory")
        u32x4 fn[10], fc[10]; f32x4 bn[4], bc[4];
#pragma unroll
        for (int kk = 0; kk < 10; ++kk) { fn[kk] = (u32x4){0u, 0u, 0u, 0u}; fc[kk] = fn[kk]; }
#pragma unroll
        for (int q = 0; q < 4; ++q) { bn[q] = (f32x4){0.f, 0.f, 0.f, 0.f}; bc[q] = bn[q]; }
        { const u16* bp = lt + (size_t)r * K + 8 * hh;
#pragma unroll
          for (int kk = 0; kk < 10; ++kk) if (kk * 16 < K) GLOAD16(fn[kk], bp + kk * 16);
          if (mat < 4) {
#pragma unroll
              for (int q = 0; q < 4; ++q) GLOAD16(bn[q], bias + 8 * q + 4 * hh); } }
        asm volatile("s_waitcnt vmcnt(0)" ::: "memory");
        for (int nt = 0; nt < 16; ++nt) {
#pragma unroll
            for (int kk = 0; kk < 10; ++kk) fc[kk] = fn[kk];
#pragma unroll
            for (int q = 0; q < 4; ++q) bc[q] = bn[q];
            asm volatile("" ::: "memory");
            if (nt + 1 < 16) { const u16* bp = lt + (size_t)((nt + 1) * 32 + r) * K + 8 * hh;
#pragma unroll
                for (int kk = 0; kk < 10; ++kk) if (kk * 16 < K) GLOAD16(fn[kk], bp + kk * 16);
                if (mat < 4) {
#pragma unroll
                    for (int q = 0; q < 4; ++q) GLOAD16(bn[q], bias + (nt + 1) * 32 + 8 * q + 4 * hh); } }
            f32x16 acc;
#pragma unroll
            for (int q = 0; q < 4; ++q)
#pragma unroll
                for (int e = 0; e < 4; ++e) acc[4 * q + e] = bc[q][e] * -1.44269504089f;
#pragma unroll
            for (int kk = 0; kk < 10; ++kk) if (kk * 16 < K) acc = __builtin_amdgcn_mfma_f32_32x32x16_bf16(__builtin_bit_cast(bf16x8, fc[kk]), af[kk], acc, 0, 0, 0);
            unsigned pkd[4][2];
#pragma unroll
            for (int q = 0; q < 4; ++q) {
                float o[4];
#pragma unroll
                for (int e = 0; e < 4; ++e) { const float x = acc[4 * q + e]; o[e] = (mat < 4) ? __builtin_amdgcn_rcpf(1.f + __builtin_amdgcn_exp2f(x)) : x; }
                pkd[q][0] = pk2(o[0], o[1]); pkd[q][1] = pk2(o[2], o[3]);
            }
#pragma unroll
            for (int p = 0; p < 2; ++p) {
                asm volatile("s_nop 1\n\tv_permlane32_swap_b32 %0, %1" : "+v"(pkd[2 * p][0]), "+v"(pkd[2 * p + 1][0]));
                asm volatile("s_nop 1\n\tv_permlane32_swap_b32 %0, %1" : "+v"(pkd[2 * p][1]), "+v"(pkd[2 * p + 1][1]));
                u32x4 w; w.x = pkd[2 * p][0]; w.y = pkd[2 * p][1]; w.z = pkd[2 * p + 1][0]; w.w = pkd[2 * p + 1][1];
                *(u32x4*)(outp + (size_t)(tok0 + r) * 512 + nt * 32 + 16 * p + 8 * hh) = w;
            }
            asm volatile("s_waitcnt vmcnt(2)" ::: "memory");
        }
        asm volatile("s_waitcnt vmcnt(0)" ::: "memory");
#undef GLOAD16
    }
}

DEVI void phase_scan(const Params& P, int l, LAS unsigned char* lds, int wv) {
    int tid_l = wv * 64 + (int)__lane_id(); asm volatile("" : "+v"(tid_l));
    unsigned char* ws = launder_ws(P.ws); asm volatile("" : "+s"(l));
    const int lane = tid_l & 63, wave = __builtin_amdgcn_readfirstlane(tid_l >> 6);
    constexpr int NS = 16, NSET = 2048 / NS, VEC = 6 * 64;
    LAS float* ring = (LAS float*)lds;
    const u16* PR = (const u16*)(ws + OFF_PR);
    const int dir = wave >> 2, rq = wave & 3, jrow = lane & 15;
    for (int bh = blockIdx.x; bh < 256; bh += gridDim.x) {
        const int b = bh >> 3, h = bh & 7, col = h * 64 + lane;
        const u16* prow = PR + (size_t)b * T_ * 2048 + h * 64;
        const float* mup = P.in[I_MUP] + l * 1952; const float* mun = P.in[I_MUN] + l * 1952;
        const float mpr = mup[col], mnr = mun[col], mpk = mup[512 + col], mnk = mun[512 + col], mpv = mup[1024 + col], mnv = mun[1024 + col];
        const float kkw = P.in[I_KK][l * 512 + col], kaw = P.in[I_KA][l * 512 + col];
        const u16* Ep = (const u16*)(ws + (dir ? OFF_EB : OFF_EF)) + (size_t)b * T_ * 512 + h * 64;
        const u16* Ap = (const u16*)(ws + (dir ? OFF_AB : OFF_AF)) + (size_t)b * T_ * 512 + h * 64;
        u16* Yp = (u16*)(ws + (dir ? OFF_YB : OFF_YF)) + (size_t)b * T_ * 512 + h * 64 + 16 * rq + 2 * (lane >> 3);
        f32x2 S2[2][4];
#pragma unroll
        for (int i = 0; i < 2; ++i)
#pragma unroll
            for (int c = 0; c < 4; ++c) S2[i][c] = (f32x2){0.f, 0.f};
        const float mAr = dir ? mnr : mpr, mBr = dir ? mpr : mnr, mAk = dir ? mnk : mpk, mBk = dir ? mpk : mnk, mAv = dir ? mnv : mpv, mBv = dir ? mpv : mnv;
        unsigned rwr[6][3], rwe[4], rwa[4];
#define SCAN_ISSUE(set_) do { const int s0_ = (set_) * NS + 4 * rq; \
            _Pragma("unroll") for (int ix = 0; ix < 6; ++ix) { int pos = s0_ - 1 + ix; pos = pos < 0 ? 0 : (pos > 2047 ? 2047 : pos); const int tm = dir ? 2047 - pos : pos; \
                const u16* pc = prow + (size_t)tm * 2048; rwr[ix][0] = pc[lane]; rwr[ix][1] = pc[512 + lane]; rwr[ix][2] = pc[1024 + lane]; } \
            _Pragma("unroll") for (int q = 0; q < 4; ++q) { const int pos = s0_ + q; const int tm = dir ? 2047 - pos : pos; \
                rwe[q] = Ep[(size_t)tm * 512 + lane]; rwa[q] = Ap[(size_t)tm * 512 + lane]; } } while (0)
#define SCAN_PRODUCE(set_) do { const int s0_ = (set_) * NS + 4 * rq; \
            _Pragma("unroll") for (int q = 0; q < 4; ++q) { \
            const int st = 4 * rq + q, pos = s0_ + q; \
            const float fA = pos > 0 ? 1.f : 0.f, fB = pos < 2047 ? 1.f : 0.f; \
            const float c0 = bf2f(rwr[q + 1][0]), c1 = bf2f(rwr[q + 1][1]), c2 = bf2f(rwr[q + 1][2]); \
            const float r_ = c0 + mAr * (fA * bf2f(rwr[q][0]) - c0) + mBr * (fB * bf2f(rwr[q + 2][0]) - c0); \
            const float k_ = c1 + mAk * (fA * bf2f(rwr[q][1]) - c1) + mBk * (fB * bf2f(rwr[q + 2][1]) - c1); \
            const float v_ = c2 + mAv * (fA * bf2f(rwr[q][2]) - c2) + mBv * (fB * bf2f(rwr[q + 2][2]) - c2); \
            const float kkv = k_ * kkw; const float ss = wave_sum_dpp(kkv * kkv); \
            const float kkn = kkv * __builtin_amdgcn_rsqf(fmaxf(ss, 1e-24f)); \
            const float a_ = bf2f(rwa[q]), w_ = __builtin_amdgcn_exp2f(bf2f(rwe[q]) * (-0.60653065971f * 1.44269504089f)); \
            LAS float* o = ring + ((((set_) & 1) * 2 + dir) * NS + st) * VEC + lane; \
            o[0] = -kkn; o[64] = w_; o[128] = kkn * a_; o[192] = k_ * (1.f + (a_ - 1.f) * kaw); o[256] = r_; o[320] = v_; } } while (0)
        SCAN_ISSUE(0);
        SCAN_PRODUCE(0);
        SCAN_ISSUE(1);
        __syncthreads();
        for (int set = 0; set < NSET; ++set) {
            if (set + 1 < NSET) SCAN_PRODUCE(set + 1);
            if (set + 2 < NSET) SCAN_ISSUE(set + 2);
            const LAS float* sb = ring + ((set & 1) * 2 + dir) * NS * VEC + 8 * (lane & 7);
            const int voff = 320 + 16 * rq + 2 * (lane >> 3) - 8 * (lane & 7);
#pragma unroll 2
            for (int st = 0; st < NS; ++st) {
                const LAS float* sm = sb + st * VEC;
                const f32x2 vv = *(const LAS f32x2*)(sm + voff);
                const f32x4 z0 = *(const LAS f32x4*)(sm), z1 = *(const LAS f32x4*)(sm + 4), w0 = *(const LAS f32x4*)(sm + 64), w1 = *(const LAS f32x4*)(sm + 68),
                            b0 = *(const LAS f32x4*)(sm + 128), b1 = *(const LAS f32x4*)(sm + 132), d0 = *(const LAS f32x4*)(sm + 192), d1 = *(const LAS f32x4*)(sm + 196),
                            r0 = *(const LAS f32x4*)(sm + 256), r1 = *(const LAS f32x4*)(sm + 260);
                const f32x2 zp[4] = {(f32x2){z0.x, z0.y}, (f32x2){z0.z, z0.w}, (f32x2){z1.x, z1.y}, (f32x2){z1.z, z1.w}};
                const f32x2 wp[4] = {(f32x2){w0.x, w0.y}, (f32x2){w0.z, w0.w}, (f32x2){w1.x, w1.y}, (f32x2){w1.z, w1.w}};
                const f32x2 bp[4] = {(f32x2){b0.x, b0.y}, (f32x2){b0.z, b0.w}, (f32x2){b1.x, b1.y}, (f32x2){b1.z, b1.w}};
                const f32x2 dp[4] = {(f32x2){d0.x, d0.y}, (f32x2){d0.z, d0.w}, (f32x2){d1.x, d1.y}, (f32x2){d1.z, d1.w}};
                const f32x2 rp[4] = {(f32x2){r0.x, r0.y}, (f32x2){r0.z, r0.w}, (f32x2){r1.x, r1.y}, (f32x2){r1.z, r1.w}};
                f32x2 sA = S2[0][0] * zp[0] + S2[0][1] * zp[1], sB = S2[0][2] * zp[2] + S2[0][3] * zp[3];
                f32x2 sC = S2[1][0] * zp[0] + S2[1][1] * zp[1], sD = S2[1][2] * zp[2] + S2[1][3] * zp[3];
                const f32x2 s0v = sA + sB, s1v = sC + sD;
                float sz0 = s0v.x + s0v.y, sz1 = s1v.x + s1v.y; red8x2(sz0, sz1);
                const f32x2 z0v = (f32x2){sz0, sz0}, z1v = (f32x2){sz1, sz1}, vxv = (f32x2){vv.x, vv.x}, vyv = (f32x2){vv.y, vv.y};
                f32x2 yA = (f32x2){0.f, 0.f}, yB = yA;
#pragma unroll
                for (int c = 0; c < 4; ++c) {
                    S2[0][c] = S2[0][c] * wp[c] + z0v * bp[c] + vxv * dp[c]; yA += S2[0][c] * rp[c];
                    S2[1][c] = S2[1][c] * wp[c] + z1v * bp[c] + vyv * dp[c]; yB += S2[1][c] * rp[c];
                }
                const float ya0 = yA.x, yb0 = yA.y, ya1 = yB.x, yb1 = yB.y;
                float y0 = ya0 + yb0, y1 = ya1 + yb1; red8x2(y0, y1);
                const int s_ = set * NS + st, tm = dir ? 2047 - s_ : s_;
                if ((lane & 7) == 0) *(unsigned*)(Yp + (size_t)tm * 512) = pk2(y0, y1);
            }
            LDS_WAIT(); __builtin_amdgcn_s_barrier();
        }
#undef SCAN_ISSUE
#undef SCAN_PRODUCE
    }
}

DEVI void phase_rwkv_post(const Params& P, int l, int wv) {
    int tid_l = wv * 64 + (int)__lane_id(); asm volatile("" : "+v"(tid_l));
    unsigned char* ws = launder_ws(P.ws); asm volatile("" : "+s"(l));
    const int lane = tid_l & 63, wave = tid_l >> 6;
    const int gw = blockIdx.x * 8 + wave, NGW = gridDim.x * 8;
    const int ch0 = lane * 8;
    const u16* PR = (const u16*)(ws + OFF_PR); const u16* AF = (const u16*)(ws + OFF_AF); const u16* AB = (const u16*)(ws + OFF_AB);
    const u16* G = (const u16*)(ws + OFF_G); const u16* YF = (const u16*)(ws + OFF_YF); const u16* YB = (const u16*)(ws + OFF_YB);
    u16* YM = (u16*)(ws + OFF_A);
    float mp[3][8], mn[3][8], ka[8], gw_[8], gb_[8], rk[8];
#pragma unroll
    for (int i = 0; i < 3; ++i) { load8f(P.in[I_MUP] + l * 1952 + i * 512 + ch0, mp[i]); load8f(P.in[I_MUN] + l * 1952 + i * 512 + ch0, mn[i]); }
    load8f(P.in[I_KA] + l * 512 + ch0, ka); load8f(P.in[I_GNW] + l * 512 + ch0, gw_); load8f(P.in[I_GNB] + l * 512 + ch0, gb_); load8f(P.in[I_RK] + l * 512 + ch0, rk);
    u32x4 cu[14], nx[14];
#define RP_LOAD(D_, tok_) do { const int t_ = (tok_) & 2047; const u16* q_ = PR + (size_t)(tok_) * 2048 + ch0; \
        _Pragma("unroll") for (int i = 0; i < 3; ++i) { D_[3 * i] = *(const u32x4*)(q_ + i * 512); D_[3 * i + 1] = *(const u32x4*)(q_ + i * 512 - (t_ > 0 ? 2048 : 0)); D_[3 * i + 2] = *(const u32x4*)(q_ + i * 512 + (t_ < T_ - 1 ? 2048 : 0)); } \
        D_[9] = *(const u32x4*)(AF + (size_t)(tok_) * 512 + ch0); D_[10] = *(const u32x4*)(AB + (size_t)(tok_) * 512 + ch0); D_[11] = *(const u32x4*)(G + (size_t)(tok_) * 512 + ch0); \
        D_[12] = *(const u32x4*)(YF + (size_t)(tok_) * 512 + ch0); D_[13] = *(const u32x4*)(YB + (size_t)(tok_) * 512 + ch0); } while (0)
    if (gw < MTOK) RP_LOAD(cu, gw);
    for (int tok = gw; tok < MTOK; tok += NGW) {
        const int t = tok & 2047;
        const int tn = tok + NGW < MTOK ? tok + NGW : tok;
        RP_LOAD(nx, tn);
        const float fp = t > 0 ? 1.f : 0.f, fn = t < T_ - 1 ? 1.f : 0.f;
        float x[3][8];
#pragma unroll
        for (int i = 0; i < 3; ++i) { float pc[8], pp[8], pn[8]; unpack8(cu[3 * i], pc); unpack8(cu[3 * i + 1], pp); unpack8(cu[3 * i + 2], pn);
#pragma unroll
            for (int j = 0; j < 8; ++j) x[i][j] = pc[j] + mp[i][j] * (fp * pp[j] - pc[j]) + mn[i][j] * (fn * pn[j] - pc[j]); }
        float af[8], ab[8], g[8], yf[8], yb[8], y[8];
        unpack8(cu[9], af); unpack8(cu[10], ab); unpack8(cu[11], g); unpack8(cu[12], yf); unpack8(cu[13], yb);
        float s = 0.f;
#pragma unroll
        for (int j = 0; j < 8; ++j) { y[j] = yf[j] + yb[j]; s += y[j]; }
        const float mean = red8(s) * (1.f / 64.f); float s2 = 0.f, bs = 0.f;
#pragma unroll
        for (int j = 0; j < 8; ++j) { y[j] -= mean; s2 += y[j] * y[j];
            const float ks = x[1][j] * (2.f + (af[j] + ab[j] - 2.f) * ka[j]); bs += x[0][j] * ks * rk[j]; }
        const float rstd = __builtin_amdgcn_rsqf(red8(s2) * (1.f / 64.f) + GN_EPS_);
        bs = red8(bs);
        float o[8];
#pragma unroll
        for (int j = 0; j < 8; ++j) o[j] = (y[j] * rstd * gw_[j] + gb_[j] + bs * x[2][j]) * g[j];
        *(u32x4*)(YM + (size_t)tok * 1024 + ch0) = pack8(o);
#pragma unroll
        for (int i = 0; i < 14; ++i) cu[i] = nx[i];
    }
#undef RP_LOAD
}

DEVI void phase_act(const Params& P, int l, size_t dst_off, int wrap_mask, int wv) {
    int tid_l = wv * 64 + (int)__lane_id(); asm volatile("" : "+v"(tid_l));
    unsigned char* ws = launder_ws(P.ws); asm volatile("" : "+s"(l));
    const int gtid = blockIdx.x * 512 + tid_l, NT = gridDim.x * 512;
    u16* UA = (u16*)(ws + OFF_UA); const u16* UG = (const u16*)(ws + OFF_UG); u16* UD = (u16*)(ws + dst_off);
    for (int idx = gtid; idx < 8192 * 352; idx += NT) {
        const int chunk = idx / 352, cg8 = (idx % 352) * 8, tok0 = chunk * 8, t0 = tok0 & 2047;
        float w0[8], w1[8], w2[8], bs[8];
        load8f(P.in[I_FCW] + ((size_t)l * 3 + 0) * 2816 + cg8, w0); load8f(P.in[I_FCW] + ((size_t)l * 3 + 1) * 2816 + cg8, w1);
        load8f(P.in[I_FCW] + ((size_t)l * 3 + 2) * 2816 + cg8, w2); load8f(P.in[I_FCB] + (size_t)l * 2816 + cg8, bs);
        const u16* ug = UG + (size_t)tok0 * 2816 + cg8; const u16* ua = UA + (size_t)tok0 * 2816 + cg8;
        u32x4 gr[10], ar[8];
        const bool hp = t0 > 0, hn = (t0 + 8) < T_;
        gr[0] = *(const u32x4*)(hp ? ug - 2816 : ug);
#pragma unroll
        for (int i = 0; i < 8; ++i) { gr[i + 1] = *(const u32x4*)(ug + (size_t)i * 2816); ar[i] = *(const u32x4*)(ua + (size_t)i * 2816); }
        gr[9] = *(const u32x4*)(hn ? ug + (size_t)8 * 2816 : ug);
        if (!hp) gr[0] = (u32x4){0u, 0u, 0u, 0u};
        if (!hn) gr[9] = (u32x4){0u, 0u, 0u, 0u};
        float prev[8], cur[8], nxt[8];
        unpack8(gr[0], prev); unpack8(gr[1], cur);
#pragma unroll
        for (int i = 0; i < 8; ++i) {
            unpack8(gr[i + 2], nxt);
            float a[8], o[8]; unpack8(ar[i], a);
#pragma unroll
            for (int j = 0; j < 8; j += 2) {
                f32x2 u = (f32x2){w0[j] * prev[j] + w1[j] * cur[j] + w2[j] * nxt[j] + bs[j], w0[j + 1] * prev[j + 1] + w1[j + 1] * cur[j + 1] + w2[j + 1] * nxt[j + 1] + bs[j + 1]};
                const f32x2 gl = pg8::gelu_pk(u); o[j] = gl.x * a[j]; o[j + 1] = gl.y * a[j + 1]; }
            *(u32x4*)(UD + (size_t)((tok0 + i) & wrap_mask) * 2816 + cg8) = pack8(o);
#pragma unroll
            for (int j = 0; j < 8; ++j) { prev[j] = cur[j]; cur[j] = nxt[j]; }
        }
    }
}

#define LAUNDER_WS() unsigned char* ws = launder_ws(P.ws); asm volatile("" : "+s"(l)); float* MOD = (float*)(ws + OFF_MOD); u16* HA = (u16*)(ws + OFF_A); const float* modl = MOD + (size_t)l * 32 * 6144; (void)modl; (void)HA
#ifndef DUP
#define DUP 0
#endif
#define REP(mask_) for (int rep_ = 0; rep_ < ((DUP & (mask_)) ? 2 : 1); ++rep_)
__global__ void __launch_bounds__(512, 2) mega_fwd(Params P) {
    extern __shared__ __attribute__((aligned(16))) unsigned char smem_[];
    LAS unsigned char* lds = (LAS unsigned char*)smem_;
    cg::grid_group grid = cg::this_grid();
    const int wv = __builtin_amdgcn_readfirstlane((int)threadIdx.x >> 6);
    volatile LAS unsigned* xst = (volatile LAS unsigned*)(lds + 131072);
    if (wv == 0 && __lane_id() == 0) { xst[0] = 0u; xst[1] = 0u; xst[2] = 0u; xst[3] = 0u; }
    __syncthreads();
    if (wv == 0 && __lane_id() == 0) (void)xb_add(&((unsigned*)P.ws)[XB_XCNT(xb_xcc_id())], 1u);
#define GSYNC() do { XcdBarrier b_; b_.bar = (unsigned*)launder_ws(P.ws); b_.x = xb_xcc_id(); b_.st = (volatile LAS unsigned*)(lds + 131072); xcd_barrier(b_, wv == 0 && __lane_id() == 0); } while (0)
    REP(16) phase_prologue(P, lds, wv);
    grid.sync();
    if (DUP & 32) { for (int i = 0; i < 20; ++i) GSYNC(); }
    REP(16) { int l = 0; LAUNDER_WS(); phase_ln<0>(P.in[I_X], nullptr, nullptr, nullptr, nullptr, nullptr, MOD + 0 * 1024, MOD + 1 * 1024, HA, wv); }
    GSYNC();
#pragma nounroll
    for (int l = 0; l < 2; ++l) {
        REP(1) { LAUNDER_WS(); EpiSplitBf16 E; E.O0 = (u16*)(ws + OFF_PR); E.O1 = (u16*)(ws + OFF_PH); E.nsplit = 8; E.ld0 = 2048; E.ld1 = 1536;
          run_gemm(lds, HA, (const u16*)(ws + OFF_WINT) + (size_t)l * 3584 * 1024, 3584, 1024, E, wv); }
        GSYNC();
        REP(4) phase_hy_prep(P, l, lds, wv);
        GSYNC();
        REP(4 | 64) phase_hy_conv(P, l, wv);
        GSYNC();
        REP(4) phase_hy_post(P, lds, wv);
        GSYNC();
        REP(8 | 128) phase_rwkv_prep(P, l, wv);
        GSYNC();
        REP(2) phase_scan(P, l, lds, wv);
        GSYNC();
        REP(8) phase_rwkv_post(P, l, wv);
        GSYNC();
        { LAUNDER_WS(); EpiSplitBf16 E; E.O0 = (u16*)(ws + OFF_B); E.O1 = E.O0; E.nsplit = 4; E.ld0 = 1024; E.ld1 = 1024;
          run_gemm(lds, HA, (const u16*)(ws + OFF_WOT) + (size_t)l * 1024 * 1024, 1024, 1024, E, wv); }
        GSYNC();
        { LAUNDER_WS(); phase_ln<1>((l == 0) ? P.in[I_X] : P.out, (const u16*)(ws + OFF_B), modl + 2 * 1024, P.out, P.in[I_LMG] + l * 1024, P.in[I_LMB] + l * 1024, modl + 3 * 1024, modl + 4 * 1024, HA, wv); }
        GSYNC();
        REP(1) { LAUNDER_WS(); EpiSplitBf16 E; E.O0 = (u16*)(ws + OFF_UA); E.O1 = (u16*)(ws + OFF_UG); E.nsplit = 11; E.ld0 = 2816; E.ld1 = 2816;
          run_gemm(lds, HA, (const u16*)(ws + OFF_WUT) + (size_t)l * 5632 * 1024, 5632, 1024, E, wv); }
        GSYNC();
        if (DUP & 512) phase_act(P, l, OFF_B + 704 * MiB, 16383, wv);
        phase_act(P, l, OFF_UA, 0x7fffffff, wv);
        GSYNC();
        { LAUNDER_WS(); EpiSplitBf16 E; E.O0 = HA; E.O1 = HA; E.nsplit = 4; E.ld0 = 1024; E.ld1 = 1024;
          run_gemm(lds, (const u16*)(ws + OFF_UA), (const u16*)(ws + OFF_WDT) + (size_t)l * 1024 * 2816, 1024, 2816, E, wv); }
        GSYNC();
        { LAUNDER_WS();
          if (l == 0) phase_ln<1>(P.out, HA, modl + 5 * 1024, P.out, P.in[I_LFG], P.in[I_LFB], MOD + (size_t)32 * 6144 + 0 * 1024, MOD + (size_t)32 * 6144 + 1 * 1024, HA, wv);
          else phase_ln<2>(P.out, HA, modl + 5 * 1024, P.out, P.in[I_LFG] + 1024, P.in[I_LFB] + 1024, nullptr, nullptr, nullptr, wv); }
        if (l == 0) GSYNC();
    }
#undef GSYNC
}

extern "C" void kernel_launch(void* const* d_in, const int* in_sizes, int n_in, void* d_out, int out_size, void* d_ws, size_t ws_size, hipStream_t stream) {
    static int grid = 0;
    constexpr int LDS_BYTES = 131072 + 16;
    if (grid == 0) {
        if (n_in != 36 || out_size != MTOK * 1024 || ws_size < WS_NEED) { fprintf(stderr, "kernel_launch: unexpected shapes (n_in %d out %d ws %zu)\n", n_in, out_size, ws_size); grid = -1; return; }
        int dev = 0, cus = 0, per_cu = 0;
        hipGetDevice(&dev); hipDeviceGetAttribute(&cus, hipDeviceAttributeMultiprocessorCount, dev);
        hipFuncSetAttribute((const void*)mega_fwd, hipFuncAttributeMaxDynamicSharedMemorySize, LDS_BYTES);
        hipOccupancyMaxActiveBlocksPerMultiprocessor(&per_cu, (const void*)mega_fwd, 512, LDS_BYTES);
        if (per_cu < 1) { fprintf(stderr, "kernel_launch: occupancy query says %d blocks/CU\n", per_cu); per_cu = 1; }
        grid = cus;
        (void)hipGetLastError();
    }
    if (grid < 0) return;
    if (hipMemsetAsync(d_ws, 0, 16384, stream) != hipSuccess) { fprintf(stderr, "kernel_launch: memset of the barrier words failed\n"); return; }
    Params p{};
    for (int i = 0; i < 36; ++i) p.in[i] = (const float*)d_in[i];
    p.out = (float*)d_out; p.ws = (unsigned char*)d_ws;
    void* args[] = {&p};
    hipError_t e = hipLaunchCooperativeKernel((const void*)mega_fwd, dim3(grid), dim3(512), args, LDS_BYTES, stream);
    if (e != hipSuccess) fprintf(stderr, "cooperative launch failed: %s (grid %d)\n", hipGetErrorString(e), grid);
}
```

```cpp
#include <hip/hip_runtime.h>
#include <hip/hip_cooperative_groups.h>
#include <cstdio>
#include <cstdint>
namespace cg = cooperative_groups;
namespace pg8 {
#define PG8_LAS __attribute__((address_space(3)))
typedef unsigned short bf16_t;
typedef short bf16x8 __attribute__((ext_vector_type(8)));
typedef float f32x4 __attribute__((ext_vector_type(4)));
typedef unsigned u32x4 __attribute__((ext_vector_type(4)));
constexpr int BM = 256, BK = 64, HALF = 128, HTB = HALF * BK * 2  , STAGE_BYTES = 8 * HTB, NXCD = 8, WGM = 4;

__host__ __device__ __forceinline__ int lds_byte(int r, int c) { const int st = (r >> 4) * 2 + (c >> 5), rr = r & 15, cc = c & 31, ob = rr * 64 + cc * 2; return st * 1024 + (ob ^ (((ob >> 9) & 1) << 5)); }
__host__ __device__ __forceinline__ void stage_rc(int b, int& R, int& C) { const int st = b / 1024, sb = b % 1024, swz = sb ^ (((sb >> 9) & 1) << 5); R = (st >> 1) * 16 + swz / 64; C = (st & 1) * 32 + (swz % 64) / 2; }
__host__ __device__ __forceinline__ int perm32(int rho) { const int n = rho >> 4, i = rho & 15; return 8 * (i >> 2) + 4 * n + (i & 3); }

struct Unit { int pm, pn; };
struct Gemm { const bf16_t* A; const bf16_t* Bt; int M, N, K; };

struct StaticOrder {
    int nM, nN, nwg, G, c;
    __host__ __device__ void init(int M, int N, int G_, int c_) { nM = M / BM; nN = N / BM; nwg = nM * nN; G = G_; c = c_; }
    __host__ __device__ bool next(int i, Unit& u) const {
        const long L = (long)i * G + c; if (L >= nwg) return false;
        int wgid = (int)L; { const int q = nwg / NXCD, r = nwg % NXCD, xcd = wgid % NXCD, off = wgid / NXCD; wgid = (xcd < r ? xcd * (q + 1) : r * (q + 1) + (xcd - r) * q) + off; }
        const int nig = WGM * nN, gid = wgid / nig, fm = gid * WGM, gsz = (nM - fm) < WGM ? (nM - fm) : WGM;
        u.pm = fm + ((wgid % nig) % gsz); u.pn = (wgid % nig) / gsz; return true;
    }
    __device__ __forceinline__ void a_ready(const Unit&) const {}
    __device__ __forceinline__ void done(const Unit&) const {}
};
__device__ __forceinline__ unsigned cvt_pk_bf16(float lo, float hi) { unsigned r; asm volatile("v_cvt_pk_bf16_f32 %0, %1, %2" : "=v"(r) : "v"(lo), "v"(hi)); return r; }
typedef float f32x2 __attribute__((ext_vector_type(2)));
__device__ __forceinline__ f32x2 gelu_pk(f32x2 v) {
    const f32x2 av = __builtin_elementwise_abs(v), d = av * 0.2316418882f + 1.0f;
    f32x2 t; t.x = __builtin_amdgcn_rcpf(d.x); t.y = __builtin_amdgcn_rcpf(d.y);
    f32x2 q = t * 0.5307027145f + (-0.7265760135f); q = q * t + 0.7107068705f; q = q * t + (-0.142248368f); q = q * t + 0.127414796f; q = q * t;
    const f32x2 s = (v * v) * (-0.72134752044f);
    f32x2 e; e.x = __builtin_amdgcn_exp2f(s.x); e.y = __builtin_amdgcn_exp2f(s.y);
    const f32x2 m = v * (q * e), r = v - m;
    f32x2 o; o.x = v.x < 0.f ? m.x : r.x; o.y = v.y < 0.f ? m.y : r.y; return o;
}
template <class Epi, class Sched, bool STAMP = false>
__device__ __forceinline__ void gemm_phase(PG8_LAS unsigned char* lds, const Gemm g, const Sched& S, const Epi& E, unsigned long long* stamps, const int wv) {
    int tid = wv * 64 + (int)__lane_id(); asm volatile("" : "+v"(tid)); const int wid = __builtin_amdgcn_readfirstlane(tid >> 6), lane = tid & 63, wr = wid >> 2, wc = wid & 3, fr = lane & 15, fq = lane >> 4;
    const int K = g.K, nt = K / BK;
    int ts_lo = 0, ts_hi = 0, nts = 0; const unsigned long long rt_entry = STAMP ? (unsigned long long)wall_clock64() : 0ull;
#define PG8_STAMP() do { if (STAMP && wid == 0 && nts < 64) { const unsigned long long _c = (unsigned long long)clock64(); \
        ts_lo = (lane == nts) ? (int)(unsigned)_c : ts_lo; ts_hi = (lane == nts) ? (int)(unsigned)(_c >> 32) : ts_hi; ++nts; } } while (0)
    PG8_STAMP();
    unsigned voffA[2], voffB[2];
#pragma unroll
    for (int i = 0; i < 2; ++i) { int R, C; stage_rc(tid * 16 + i * 8192, R, C); const int Rb = Epi::PERM ? ((R & ~31) + perm32(R & 31)) : R;
        voffA[i] = (unsigned)(R * K + C) * 2u; voffB[i] = (unsigned)(Rb * K + C) * 2u; }
    const size_t kstep = (size_t)(BK * 2);
    const size_t hstep = (size_t)HALF * K * 2;
    const size_t tstep = 2 * hstep;
    const unsigned ldsw = (unsigned)wid * 1024u;
    const int aoff = lds_byte(wr * 64 + fr, fq * 8), boff = lds_byte(wc * 32 + fr, fq * 8);
#define PG8_SA(b, h) (((b) * 2 + (h)) * HTB)
#define PG8_SB(b, h) ((4 + (b) * 2 + (h)) * HTB)
#define PG8_STAGE(bufoff, gbase, voff) do { _Pragma("unroll") for (int _i = 0; _i < 2; ++_i) \
        __builtin_amdgcn_global_load_lds((const unsigned*)((const char*)(gbase) + (voff)[_i]), (PG8_LAS unsigned*)(lds + (bufoff) + ldsw + _i * 8192), 16, 0, 0); } while (0)
#define PG8_LDA(dst, b, h) do { _Pragma("unroll") for (int m = 0; m < 4; ++m) _Pragma("unroll") for (int k = 0; k < 2; ++k) dst[m][k] = *(const PG8_LAS bf16x8*)(lds + PG8_SA(b, h) + aoff + m * 2048 + k * 1024); } while (0)
#define PG8_LDB(dst, b, h) do { _Pragma("unroll") for (int n = 0; n < 2; ++n) _Pragma("unroll") for (int k = 0; k < 2; ++k) dst[n][k] = *(const PG8_LAS bf16x8*)(lds + PG8_SB(b, h) + boff + n * 2048 + k * 1024); } while (0)
#define PG8_MMA(ai, bj, At, Bt) do { __builtin_amdgcn_s_setprio(1); _Pragma("unroll") for (int m = 0; m < 4; ++m) _Pragma("unroll") for (int n = 0; n < 2; ++n) _Pragma("unroll") for (int k = 0; k < 2; ++k) \
        acc[ai][bj][m][n] = __builtin_amdgcn_mfma_f32_16x16x32_bf16(Bt[n][k], At[m][k], acc[ai][bj][m][n], 0, 0, 0); __builtin_amdgcn_s_setprio(0); } while (0)
#define PG8_WAIT_V(n) asm volatile("s_waitcnt vmcnt(" #n ")" ::: "memory")
#define PG8_WAIT_L(n) asm volatile("s_waitcnt lgkmcnt(" #n ")" ::: "memory")
#define PG8_BAR __builtin_amdgcn_s_barrier()
#define PG8_SCHED __builtin_amdgcn_sched_barrier(0)
    Unit cur, nxt; int ui = 0;
    if (!S.next(0, cur)) return;
    f32x4 acc[2][2][4][2];
#pragma unroll
    for (int a = 0; a < 2; ++a)
#pragma unroll
        for (int b = 0; b < 2; ++b)
#pragma unroll
            for (int m = 0; m < 4; ++m)
#pragma unroll
                for (int n = 0; n < 2; ++n) acc[a][b][m][n] = (f32x4){0.f, 0.f, 0.f, 0.f};
    bf16x8 At[4][2], B0[2][2], B1[2][2];
    const char* cA = (const char*)g.A + (size_t)cur.pm * tstep; const char* cB = (const char*)g.Bt + (size_t)cur.pn * tstep;
    S.a_ready(cur);
    PG8_STAGE(PG8_SB(0, 0), cB, voffB); PG8_STAGE(PG8_SA(0, 0), cA, voffA); PG8_STAGE(PG8_SB(0, 1), cB + hstep, voffB); PG8_STAGE(PG8_SA(0, 1), cA + hstep, voffA);
    if (wr == 1) PG8_BAR;
    PG8_WAIT_V(4); PG8_BAR;
    PG8_STAGE(PG8_SB(1, 0), cB + kstep, voffB); PG8_STAGE(PG8_SA(1, 0), cA + kstep, voffA); PG8_STAGE(PG8_SB(1, 1), cB + hstep + kstep, voffB);
    PG8_WAIT_V(6); PG8_BAR;
    PG8_STAMP();
    for (;;) {
        const bool has_next = S.next(ui + 1, nxt);
        const char* nA = has_next ? (const char*)g.A + (size_t)nxt.pm * tstep : cA; const char* nB = has_next ? (const char*)g.Bt + (size_t)nxt.pn * tstep : cB;
        for (int t = 0; t < nt; t += 2) {
            const bool last = (t == nt - 2);
            const char* a1 = cA + (size_t)(t + 1) * kstep;
            const char* a2 = last ? nA : cA + (size_t)(t + 2) * kstep; const char* b2 = last ? nB : cB + (size_t)(t + 2) * kstep;
            const char* a3 = a2 + kstep; const char* b3 = b2 + kstep;
            if (last && has_next) S.a_ready(nxt);
            PG8_LDB(B0, 0, 0); PG8_SCHED; PG8_LDA(At, 0, 0); PG8_STAGE(PG8_SA(1, 1), a1 + hstep, voffA);
            PG8_WAIT_L(8); PG8_BAR; PG8_WAIT_L(0); PG8_MMA(0, 0, At, B0); PG8_BAR; PG8_SCHED;
            PG8_LDB(B1, 0, 1); PG8_STAGE(PG8_SB(0, 0), b2, voffB);
            PG8_BAR; PG8_WAIT_L(0); PG8_MMA(0, 1, At, B1); PG8_BAR;
            PG8_LDA(At, 0, 1); PG8_STAGE(PG8_SA(0, 0), a2, voffA);
            PG8_BAR; PG8_WAIT_L(0); PG8_MMA(1, 0, At, B0); PG8_BAR; PG8_SCHED;
            PG8_STAGE(PG8_SB(0, 1), b2 + hstep, voffB);
            PG8_WAIT_V(6); PG8_BAR; PG8_MMA(1, 1, At, B1); PG8_BAR;
            PG8_LDB(B0, 1, 0); PG8_SCHED; PG8_LDA(At, 1, 0); PG8_STAGE(PG8_SA(0, 1), a2 + hstep, voffA);
            PG8_WAIT_L(8); PG8_BAR; PG8_WAIT_L(0); PG8_MMA(0, 0, At, B0); PG8_BAR; PG8_SCHED;
            PG8_LDB(B1, 1, 1); PG8_STAGE(PG8_SB(1, 0), b3, voffB);
            PG8_BAR; PG8_WAIT_L(0); PG8_MMA(0, 1, At, B1); PG8_BAR;
            PG8_LDA(At, 1, 1); PG8_STAGE(PG8_SA(1, 0), a3, voffA);
            PG8_BAR; PG8_WAIT_L(0); PG8_MMA(1, 0, At, B0); PG8_BAR; PG8_SCHED;
            PG8_STAGE(PG8_SB(1, 1), b3 + hstep, voffB);
            PG8_WAIT_V(6); PG8_BAR; PG8_MMA(1, 1, At, B1); PG8_BAR;
        }
        PG8_STAMP();
        if constexpr (!Epi::AFTER_DRAIN) { E(acc, cur, wr, wc, fr, fq); S.done(cur); }
        PG8_STAMP();
        if (!has_next) break;
#pragma unroll
        for (int a = 0; a < 2; ++a)
#pragma unroll
            for (int b = 0; b < 2; ++b)
#pragma unroll
                for (int m = 0; m < 4; ++m)
#pragma unroll
                    for (int n = 0; n < 2; ++n) acc[a][b][m][n] = (f32x4){0.f, 0.f, 0.f, 0.f};
        cur = nxt; cA = nA; cB = nB; ++ui;
    }
    PG8_WAIT_V(0);
    if (wr == 0) PG8_BAR;
    PG8_BAR;
    if constexpr (Epi::AFTER_DRAIN) { E.fused(acc, cur, wr, wc, fr, fq, lds, wid, lane); S.done(cur); }
    PG8_STAMP();
    if (STAMP && wid == 0) { stamps[lane] = lane < nts ? (((unsigned long long)(unsigned)ts_hi << 32) | (unsigned)ts_lo) : 0ull;
        if (lane == 62) stamps[62] = rt_entry; if (lane == 63) stamps[63] = (unsigned long long)wall_clock64(); }
#undef PG8_STAMP
#undef PG8_SA
#undef PG8_SB
#undef PG8_STAGE
#undef PG8_LDA
#undef PG8_LDB
#undef PG8_MMA
#undef PG8_WAIT_V
#undef PG8_WAIT_L
#undef PG8_BAR
#undef PG8_SCHED
}
}

using pg8::bf16_t; using pg8::bf16x8; using pg8::f32x4; using pg8::u32x4; using pg8::Unit; using pg8::f32x2;
typedef unsigned short u16;
typedef float f32x16 __attribute__((ext_vector_type(16)));
typedef bf16x8 bf16x8_a4 __attribute__((aligned(4)));
typedef u32x4 u32x4_a4 __attribute__((aligned(4)));
typedef unsigned u32x2 __attribute__((ext_vector_type(2)));
#define DEVI __device__ __forceinline__
#define LAS __attribute__((address_space(3)))
#define LDS_WAIT() asm volatile("s_waitcnt lgkmcnt(0)" ::: "memory")
#define GAS __attribute__((address_space(1)))
DEVI unsigned char* launder_ws(unsigned char* p) { GAS unsigned char* g = (GAS unsigned char*)p; asm volatile("" : "+s"(g)); return (unsigned char*)g; }

#define XB_TMO      128
#define XB_XCNT(j)  (256  + 64 * (j))
#define XB_XSUB(j)  (1280 + 64 * (j))
#define XB_XGEN(j)  (2304 + 64 * (j))
#define XB_TOP      3328
#define XB_TOPGEN   3392
#define XCD_BAR_WORDS 3456
#define XB_SPIN_CAP (1u << 18)
__device__ __forceinline__ unsigned xb_ld(unsigned* p)              { return __hip_atomic_load(p, __ATOMIC_RELAXED, __HIP_MEMORY_SCOPE_AGENT); }
__device__ __forceinline__ unsigned xb_add(unsigned* p, unsigned v) { return __hip_atomic_fetch_add(p, v, __ATOMIC_RELAXED, __HIP_MEMORY_SCOPE_AGENT); }
__device__ __forceinline__ unsigned xb_xcc_id() { return (unsigned)__builtin_amdgcn_s_getreg((3 << 11) | 20) & 0xFu; }
#define XB_SPIN(cond, bar) do { unsigned _sp = 0; while (cond) { __builtin_amdgcn_s_sleep(1); \
    if ((++_sp & 255u) == 0u) { if (xb_ld(&(bar)[XB_TMO])) break; if (_sp > XB_SPIN_CAP) { atomicAdd(&(bar)[XB_TMO], 1u); break; } } } } while (0)

struct XcdBarrier {
    unsigned* bar; unsigned x;
    volatile LAS unsigned* st;
};

__device__ __forceinline__ XcdBarrier xcd_barrier_post(unsigned* bar, volatile LAS unsigned* st) {
    XcdBarrier b; b.bar = bar; b.x = xb_xcc_id(); b.st = st;
    if (threadIdx.x == 0) (void)xb_add(&bar[XB_XCNT(b.x)], 1u);
    return b;
}
__device__ __forceinline__ void xcd_barrier_complete(unsigned* bar, unsigned x, unsigned& nloc, unsigned& nx) {
    const unsigned G = gridDim.x * gridDim.y * gridDim.z;
    unsigned sum, cnt, mine, sp = 0u;
    for (;;) {
        sum = 0u; cnt = 0u; mine = 0u;
#pragma unroll
        for (unsigned j = 0; j < 16; ++j) { const unsigned c = xb_ld(&bar[XB_XCNT(j)]); sum += c; cnt += (c > 0u) ? 1u : 0u; mine = (j == x) ? c : mine; }
        if (sum == G) break;
        __builtin_amdgcn_s_sleep(1);
        if ((++sp & 255u) == 0u) { if (xb_ld(&bar[XB_TMO])) break; if (sp > XB_SPIN_CAP) { atomicAdd(&bar[XB_TMO], 1u); break; } }
    }
    nloc = mine > 0u ? mine : 1u; nx = cnt > 0u ? cnt : 1u;
}

__device__ __forceinline__ void xcd_barrier(const XcdBarrier& b, const bool leader) {
    asm volatile("s_waitcnt vmcnt(0)" ::: "memory");
    __syncthreads();
    if (leader) {
        unsigned* bar = b.bar;
        __builtin_amdgcn_s_waitcnt(0);
        unsigned nloc = b.st[0], nx = b.st[1];
        if (nloc == 0u) { xcd_barrier_complete(bar, b.x, nloc, nx); b.st[0] = nloc; b.st[1] = nx; }
        const unsigned old = xb_add(&bar[XB_XSUB(b.x)], 1u);
        const unsigned gen = old / nloc;
        if (old + 1u == (gen + 1u) * nloc) {
            __builtin_amdgcn_fence(__ATOMIC_RELEASE, "agent");
            asm volatile("s_waitcnt vmcnt(0)" ::: "memory");
            const unsigned og = xb_add(&bar[XB_TOP], 1u);
            const unsigned tg = og / nx;
            if (og + 1u == (tg + 1u) * nx) xb_add(&bar[XB_TOPGEN], 1u);
            else XB_SPIN(xb_ld(&bar[XB_TOPGEN]) == tg, bar);
            __builtin_amdgcn_fence(__ATOMIC_ACQUIRE, "agent");
            xb_add(&bar[XB_XGEN(b.x)], 1u);
            asm volatile("s_waitcnt vmcnt(0)" ::: "memory");
        } else {
            XB_SPIN(xb_ld(&bar[XB_XGEN(b.x)]) == gen, bar);
            __builtin_amdgcn_fence(__ATOMIC_ACQUIRE, "agent");
            asm volatile("s_waitcnt vmcnt(0)" ::: "memory");
        }
    }
    __syncthreads();
}

constexpr int T_ = 2048, MTOK = 65536;
constexpr float ALPHA_ = 1.41421356237f, LN_EPS_ = 1e-5f, GN_EPS_ = 64e-5f;
constexpr size_t MiB = 1u << 20;
constexpr size_t OFF_WINT = 1 * MiB, OFF_WOT = 15 * MiB, OFF_WUT = 19 * MiB, OFF_WDT = 41 * MiB, OFF_LT = 52 * MiB, OFF_MOD = 53 * MiB, OFF_GT = 55 * MiB,
                 OFF_A = 72 * MiB, OFF_B = 200 * MiB;
constexpr size_t OFF_PR = OFF_B, OFF_PH = OFF_B + 256 * MiB, OFF_UT = OFF_B + 448 * MiB, OFF_X0 = OFF_B + 512 * MiB, OFF_CONVT = OFF_B + 576 * MiB;
constexpr size_t OFF_EF = OFF_B + 256 * MiB, OFF_EB = OFF_B + 320 * MiB, OFF_AF = OFF_B + 384 * MiB, OFF_AB = OFF_B + 448 * MiB, OFF_G = OFF_B + 512 * MiB,
                 OFF_YF = OFF_B + 576 * MiB, OFF_YB = OFF_B + 640 * MiB;
constexpr size_t OFF_UA = OFF_B, OFF_UG = OFF_B + 352 * MiB;
constexpr size_t WS_NEED = OFF_B + 704 * MiB;
constexpr int GT_STRIDE = 4112;
constexpr int LT_PER_LAYER = 2 * 512 * 64 * 2 + 512 * 160;

struct Params { const float* in[36]; float* out; unsigned char* ws; };
enum { I_X = 0, I_C, I_WADA, I_BADA, I_ADAT, I_WIN, I_MUP, I_MUN, I_HCW, I_HCB, I_W0, I_WUP, I_A0, I_AUP, I_GUP, I_KK, I_KA, I_RK, I_GNW, I_GNB,
       I_FW1, I_FB1, I_FWIN, I_FBIN, I_FFREQ, I_FWOUT, I_HBIAS, I_WOUT, I_LMG, I_LMB, I_FUP, I_FCW, I_FCB, I_FDN, I_LFG, I_LFB };

DEVI u16 f2bf(float f) { unsigned u = __float_as_uint(f); u += 0x7FFFu + ((u >> 16) & 1u); return (u16)(u >> 16); }
DEVI float bf2f(unsigned b) { return __uint_as_float(b << 16); }
DEVI float bflo(unsigned w) { return __uint_as_float(w << 16); }
DEVI float bfhi(unsigned w) { return __uint_as_float(w & 0xFFFF0000u); }
DEVI unsigned pk2(float lo, float hi) { return pg8::cvt_pk_bf16(lo, hi); }
DEVI float wave_sum(float v) {
#pragma unroll
    for (int o = 1; o < 64; o <<= 1) v += __shfl_xor(v, o);
    return v;
}
DEVI float sum8(float v) { v += __shfl_xor(v, 1); v += __shfl_xor(v, 2); v += __shfl_xor(v, 4); return v; }
DEVI float sigmoidf_(float x) { return __builtin_amdgcn_rcpf(1.f + __expf(-x)); }
DEVI float tanhf_(float x) { return 1.f - 2.f * __builtin_amdgcn_rcpf(__expf(2.f * x) + 1.f); }
DEVI void unpack8(const u32x4 w, float (&o)[8]) { o[0] = bflo(w.x); o[1] = bfhi(w.x); o[2] = bflo(w.y); o[3] = bfhi(w.y); o[4] = bflo(w.z); o[5] = bfhi(w.z); o[6] = bflo(w.w); o[7] = bfhi(w.w); }
DEVI u32x4 pack8(const float (&v)[8]) { u32x4 w; w.x = pk2(v[0], v[1]); w.y = pk2(v[2], v[3]); w.z = pk2(v[4], v[5]); w.w = pk2(v[6], v[7]); return w; }
DEVI void load8f(const float* p, float (&o)[8]) { const f32x4 a = *(const f32x4*)p, b = *(const f32x4*)(p + 4); o[0] = a.x; o[1] = a.y; o[2] = a.z; o[3] = a.w; o[4] = b.x; o[5] = b.y; o[6] = b.z; o[7] = b.w; }

#define FMAC_DPP(acc_, d_, o_, N_) asm("v_fmac_f32_dpp %0, %1, %2 row_ror:" #N_ " row_mask:0xf bank_mask:0xf" : "+v"(acc_) : "v"(d_), "v"(o_))
#define MUL_DPP(dst_, d_, o_, N_) asm("v_mul_f32_dpp %0, %1, %2 row_ror:" #N_ " row_mask:0xf bank_mask:0xf" : "=v"(dst_) : "v"(d_), "v"(o_))
DEVI float red4(float x) {
    float a = x, b = x;
    asm volatile("s_nop 1\n\tv_permlane16_swap_b32 %0, %1" : "+v"(a), "+v"(b));
    const float s = a + b;
    a = s; b = s;
    asm volatile("s_nop 1\n\tv_permlane32_swap_b32 %0, %1" : "+v"(a), "+v"(b));
    return a + b;
}
DEVI float red8(float x) {
    float t;
    asm("s_nop 1\n\tv_add_f32_dpp %0, %1, %1 quad_perm:[1,0,3,2] row_mask:0xf bank_mask:0xf" : "=v"(t) : "v"(x)); x = t;
    asm("s_nop 1\n\tv_add_f32_dpp %0, %1, %1 quad_perm:[2,3,0,1] row_mask:0xf bank_mask:0xf" : "=v"(t) : "v"(x)); x = t;
    asm("s_nop 1\n\tv_add_f32_dpp %0, %1, %1 row_half_mirror row_mask:0xf bank_mask:0xf" : "=v"(t) : "v"(x));
    return t;
}
DEVI void red8x2(float& x0, float& x1) {
    asm volatile("s_nop 1\n\t"
                 "v_add_f32_dpp %0, %0, %0 quad_perm:[1,0,3,2] row_mask:0xf bank_mask:0xf\n\t"
                 "v_add_f32_dpp %1, %1, %1 quad_perm:[1,0,3,2] row_mask:0xf bank_mask:0xf\n\t"
                 "s_nop 0\n\t"
                 "v_add_f32_dpp %0, %0, %0 quad_perm:[2,3,0,1] row_mask:0xf bank_mask:0xf\n\t"
                 "v_add_f32_dpp %1, %1, %1 quad_perm:[2,3,0,1] row_mask:0xf bank_mask:0xf\n\t"
                 "s_nop 0\n\t"
                 "v_add_f32_dpp %0, %0, %0 row_half_mirror row_mask:0xf bank_mask:0xf\n\t"
                 "v_add_f32_dpp %1, %1, %1 row_half_mirror row_mask:0xf bank_mask:0xf"
                 : "+v"(x0), "+v"(x1));
}
DEVI float wave_sum_dpp(float x) {
    float t;
    asm("s_nop 1\n\tv_add_f32_dpp %0, %1, %1 row_ror:1 row_mask:0xf bank_mask:0xf" : "=v"(t) : "v"(x)); x = t;
    asm("s_nop 1\n\tv_add_f32_dpp %0, %1, %1 row_ror:2 row_mask:0xf bank_mask:0xf" : "=v"(t) : "v"(x)); x = t;
    asm("s_nop 1\n\tv_add_f32_dpp %0, %1, %1 row_ror:4 row_mask:0xf bank_mask:0xf" : "=v"(t) : "v"(x)); x = t;
    asm("s_nop 1\n\tv_add_f32_dpp %0, %1, %1 row_ror:8 row_mask:0xf bank_mask:0xf" : "=v"(t) : "v"(x)); x = t;
    return red4(x);
}

struct EpiSplitBf16 {
    static constexpr bool PERM = true, AFTER_DRAIN = false;
    u16* O0; u16* O1; int nsplit, ld0, ld1;
    __device__ __forceinline__ void operator()(const f32x4 (&acc)[2][2][4][2], const Unit& u, int wr, int wc, int fr, int fq) const {
        const int row0 = u.pm * 256 + wr * 64 + fr;
        u16* base; int ldc, colt;
        if (u.pn < nsplit) { base = O0; ldc = ld0; colt = u.pn * 256; } else { base = O1; ldc = ld1; colt = (u.pn - nsplit) * 256; }
        const int col0 = colt + wc * 32 + 8 * fq;
#pragma unroll
        for (int ai = 0; ai < 2; ++ai)
#pragma unroll
            for (int m = 0; m < 4; ++m) { u16* rowp = base + (size_t)(row0 + ai * 128 + m * 16) * ldc + col0;
#pragma unroll
                for (int bj = 0; bj < 2; ++bj) { const f32x4 v0 = acc[ai][bj][m][0], v1 = acc[ai][bj][m][1];
                    u32x4 w; w.x = pk2(v0[0], v0[1]); w.y = pk2(v0[2], v0[3]); w.z = pk2(v1[0], v1[1]); w.w = pk2(v1[2], v1[3]);
                    *(u32x4*)(rowp + bj * 128) = w; } }
    }
};
struct EpiRes {
    static constexpr bool PERM = false, AFTER_DRAIN = false;
    const float* xin; float* xout; const float* gate;
    __device__ __forceinline__ void operator()(const f32x4 (&acc)[2][2][4][2], const Unit& u, int wr, int wc, int fr, int fq) const {
        const int row0 = u.pm * 256 + wr * 64 + fr, col0 = u.pn * 256 + wc * 32 + 4 * fq;
        const float* gp = gate + (size_t)(u.pm >> 3) * 6144 + col0;
        f32x4 gv[2][2];
#pragma unroll
        for (int bj = 0; bj < 2; ++bj)
#pragma unroll
            for (int n = 0; n < 2; ++n) gv[bj][n] = *(const f32x4*)(gp + bj * 128 + n * 16) + 1.0f;
#pragma unroll
        for (int ai = 0; ai < 2; ++ai)
#pragma unroll
            for (int m = 0; m < 4; ++m) { const size_t off = (size_t)(row0 + ai * 128 + m * 16) * 1024 + col0;
#pragma unroll
                for (int bj = 0; bj < 2; ++bj)
#pragma unroll
                    for (int n = 0; n < 2; ++n) { const f32x4 xv = *(const f32x4*)(xin + off + bj * 128 + n * 16);
                        *(f32x4*)(xout + off + bj * 128 + n * 16) = xv * ALPHA_ + gv[bj][n] * acc[ai][bj][m][n]; } }
    }
};

template <class Epi> DEVI void run_gemm(LAS unsigned char* lds, const u16* A, const u16* Bt, int N, int K, const Epi& E, int wv) {
    pg8::Gemm g; g.A = A; g.Bt = Bt; g.M = MTOK; g.N = N; g.K = K;
    pg8::StaticOrder S; S.init(MTOK, N, (int)gridDim.x, (int)blockIdx.x);
    pg8::gemm_phase<Epi, pg8::StaticOrder, false>(lds, g, S, E, nullptr, wv);
}

DEVI void transpose_item(const float* W, int K, int N, u16* WT, int drow, LAS float* scr, int k0, int n0, int lane) {
#pragma unroll 8
    for (int i = 0; i < 32; ++i) { const int kk = 2 * i + (lane >> 5); scr[kk * 33 + (lane & 31)] = W[(size_t)(k0 + kk) * N + n0 + (lane & 31)]; }
    LDS_WAIT();
    const int c = lane & 7;
#pragma unroll
    for (int j = 0; j < 4; ++j) { const int n = (lane >> 3) + 8 * j; const LAS float* s = scr + (8 * c) * 33 + n;
        u32x4 o; o.x = pk2(s[0 * 33], s[1 * 33]); o.y = pk2(s[2 * 33], s[3 * 33]); o.z = pk2(s[4 * 33], s[5 * 33]); o.w = pk2(s[6 * 33], s[7 * 33]);
        *(u32x4*)(WT + (size_t)(drow + n) * K + k0 + 8 * c) = o; }
    LDS_WAIT();
}

DEVI void phase_prologue(const Params& P, LAS unsigned char* lds, int wv) {
    int tid_l = wv * 64 + (int)__lane_id(); asm volatile("" : "+v"(tid_l));
    const int tid = tid_l, lane = tid & 63, wave = tid >> 6;
    unsigned char* ws = launder_ws(P.ws);
    float* MOD = (float*)(ws + OFF_MOD);
#if defined(PROBE_VALU)
    {
        float a[16]; float z = (float)tid * 1e-3f;
#pragma unroll
        for (int i = 0; i < 16; ++i) a[i] = (float)(tid + i) * 1e-4f;
        for (int it = 0; it < PROBE_N; ++it) {
#if PROBE_VALU == 1
            FMAC_DPP(a[1], z, a[0], 1); FMAC_DPP(a[2], z, a[0], 2); FMAC_DPP(a[3], z, a[0], 3); FMAC_DPP(a[4], z, a[0], 4); FMAC_DPP(a[5], z, a[0], 5);
            FMAC_DPP(a[6], z, a[0], 6); FMAC_DPP(a[7], z, a[0], 7); FMAC_DPP(a[8], z, a[0], 8); FMAC_DPP(a[9], z, a[0], 9); FMAC_DPP(a[10], z, a[0], 10);
            FMAC_DPP(a[11], z, a[0], 11); FMAC_DPP(a[12], z, a[0], 12); FMAC_DPP(a[13], z, a[0], 13); FMAC_DPP(a[14], z, a[0], 14); FMAC_DPP(a[15], z, a[0], 15);
#else
#pragma unroll
            for (int i = 1; i < 16; ++i) asm volatile("v_fmac_f32_e32 %0, %1, %2" : "+v"(a[i]) : "v"(z), "v"(a[0]));
#endif
            asm volatile("" : "+v"(a[0]));
        }
        float sum = 0.f;
#pragma unroll
        for (int i = 0; i < 16; ++i) sum += a[i];
        if (sum == 123.456f) MOD[0] = sum;
    }
#endif
    {
        LAS float* red = (LAS float*)lds;
        const float* cin = P.in[I_C]; const float* W = P.in[I_WADA];
        const int r = lane & 31, hh = lane >> 5;
        for (int item = blockIdx.x; item < 192; item += gridDim.x) {
            const int n0 = item * 32;
            f32x16 acc;
#pragma unroll
            for (int i = 0; i < 16; ++i) acc[i] = 0.f;
#pragma unroll 16
            for (int ks = 0; ks < 64; ++ks) {
                const int k = wave * 128 + ks * 2 + hh;
                const float cv = cin[r * 1024 + k]; const float a = cv / (1.f + expf(-cv));
                const float bv = W[(size_t)k * 6144 + n0 + r];
                acc = __builtin_amdgcn_mfma_f32_32x32x2f32(a, bv, acc, 0, 0, 0);
            }
#pragma unroll
            for (int rg = 0; rg < 16; ++rg) { const int row = (rg & 3) + 8 * (rg >> 2) + 4 * hh; red[(wave * 32 + row) * 32 + r] = acc[rg]; }
            __syncthreads();
            for (int e = tid; e < 1024; e += 512) {
                const int row = e >> 5, col = e & 31; float s = 0.f;
#pragma unroll
                for (int w = 0; w < 8; ++w) s += red[(w * 32 + row) * 32 + col];
                const int n = n0 + col; s += P.in[I_BADA][n];
                const int gi = n >> 10, nn = n & 1023;
#pragma unroll
                for (int l = 0; l < 2; ++l) MOD[((size_t)(l * 32 + row) * 6 + gi) * 1024 + nn] = s + P.in[I_ADAT][(l * 6 + gi) * 1024 + nn];
            }
            __syncthreads();
        }
    }
    {
        LAS float* scr = (LAS float*)(lds + 32768) + wave * (64 * 33);
        const int gw = blockIdx.x * 8 + wave, NGW = gridDim.x * 8;
        u16* WINT = (u16*)(ws + OFF_WINT); u16* WOT = (u16*)(ws + OFF_WOT); u16* WUT = (u16*)(ws + OFF_WUT); u16* WDT = (u16*)(ws + OFF_WDT);
        for (int it = gw; it < 2 * 6480; it += NGW) {
            const int l = it / 6480; int r = it % 6480;
            if (r < 1744) { const int kb = r / 109, nb = r % 109, n0 = nb * 32, drow = n0 < 1952 ? n0 : n0 + 96;
                transpose_item(P.in[I_WIN] + (size_t)l * 1024 * 3488, 1024, 3488, WINT + (size_t)l * 3584 * 1024, drow, scr, kb * 64, n0, lane); continue; }
            r -= 1744;
            if (r < 512) { const int kb = r / 32, nb = r % 32;
                transpose_item(P.in[I_WOUT] + (size_t)l * 1024 * 1024, 1024, 1024, WOT + (size_t)l * 1024 * 1024, nb * 32, scr, kb * 64, nb * 32, lane); continue; }
            r -= 512;
            if (r < 2816) { const int kb = r / 176, nb = r % 176;
                transpose_item(P.in[I_FUP] + (size_t)l * 1024 * 5632, 1024, 5632, WUT + (size_t)l * 5632 * 1024, nb * 32, scr, kb * 64, nb * 32, lane); continue; }
            r -= 2816;
            { const int kb = r / 32, nb = r % 32;
                transpose_item(P.in[I_FDN] + (size_t)l * 2816 * 1024, 2816, 1024, WDT + (size_t)l * 1024 * 2816, nb * 32, scr, kb * 64, nb * 32, lane); }
        }
        const int gtid = blockIdx.x * 512 + tid, NT = gridDim.x * 512;
        for (int i = gtid; i < 2 * 96 * 128; i += NT) { const int l = i / (96 * 128), rr = i % (96 * 128);
            *(u32x4*)(WINT + (size_t)l * 3584 * 1024 + (size_t)1952 * 1024 + (size_t)rr * 8) = (u32x4){0u, 0u, 0u, 0u}; }
        u16* LT = (u16*)(ws + OFF_LT);
        for (int i = gtid; i < 2 * LT_PER_LAYER; i += NT) {
            const int l = i / LT_PER_LAYER; int e = i % LT_PER_LAYER; float v;
            if (e < 65536) { const int d = e >> 15, n = (e >> 6) & 511, k = e & 63; v = P.in[I_WUP][((size_t)(l * 2 + d) * 64 + k) * 512 + n]; }
            else if (e < 131072) { const int e2 = e - 65536; const int d = e2 >> 15, n = (e2 >> 6) & 511, k = e2 & 63; v = P.in[I_AUP][((size_t)(l * 2 + d) * 64 + k) * 512 + n]; }
            else { const int e2 = e - 131072; const int n = e2 / 160, k = e2 % 160; v = P.in[I_GUP][((size_t)l * 160 + k) * 512 + n]; }
            LT[i] = f2bf(e < 131072 ? v * -1.44269504089f : v);
        }
    }
    __syncthreads();
    {
        LAS float* zb = (LAS float*)lds;
        LAS float* hb0 = zb + 8 * 36;
        LAS float* hb1 = hb0 + 64 * 8;
        u16* GT = (u16*)(ws + OFF_GT);
        const int p = tid >> 6, j = tid & 63;
        for (int item = blockIdx.x; item < 512; item += gridDim.x) {
            const int l = item >> 8, i0 = (item & 255) * 8, i = i0 + p;
            const float t = (float)i * (1.0f / 2047.0f);
            if (j < 33) {
                float z;
                if (j == 0) z = t;
                else { const int bnd = (j - 1) & 15; const float f = 1e-4f + (float)bnd * ((15.0f - 1e-4f) / 15.0f);
                    const float ang = (6.283185307179586f / 2048.0f) * (float)i * f; z = (j <= 16) ? cosf(ang) : -sinf(ang); }
                zb[p * 36 + j] = z;
            }
            __syncthreads();
            const float fr = P.in[I_FFREQ][l * 64 + j];
            { float a = P.in[I_FB1][l * 64 + j]; const float* w1 = P.in[I_FW1] + (size_t)l * 33 * 64 + j;
#pragma unroll 11
                for (int m = 0; m < 33; ++m) a += zb[p * 36 + m] * w1[m * 64];
                hb0[j * 8 + p] = sinf(fr * a); }
            __syncthreads();
            { float a = P.in[I_FBIN][(l * 2 + 0) * 64 + j]; const float* w = P.in[I_FWIN] + (size_t)(l * 2 + 0) * 4096 + j;
#pragma unroll 16
                for (int m = 0; m < 64; ++m) a += hb0[m * 8 + p] * w[m * 64];
                hb1[j * 8 + p] = sinf(fr * a); }
            __syncthreads();
            { float a = P.in[I_FBIN][(l * 2 + 1) * 64 + j]; const float* w = P.in[I_FWIN] + (size_t)(l * 2 + 1) * 4096 + j;
#pragma unroll 16
                for (int m = 0; m < 64; ++m) a += hb1[m * 8 + p] * w[m * 64];
                a = sinf(fr * a);
                __syncthreads();
                hb0[j * 8 + p] = a; }
            __syncthreads();
#pragma unroll
            for (int qq = 0; qq < 2; ++qq) {
                const int n = j + 64 * (p + 8 * qq);
                float acc8[8];
#pragma unroll
                for (int pp = 0; pp < 8; ++pp) acc8[pp] = 0.f;
                const float* wo = P.in[I_FWOUT] + (size_t)l * 64 * 1024 + n;
#pragma unroll 16
                for (int m = 0; m < 64; ++m) { const float w = wo[m * 1024]; const f32x4 h0 = *(const LAS f32x4*)(hb0 + m * 8), h1 = *(const LAS f32x4*)(hb0 + m * 8 + 4);
                    acc8[0] += h0.x * w; acc8[1] += h0.y * w; acc8[2] += h0.z * w; acc8[3] += h0.w * w; acc8[4] += h1.x * w; acc8[5] += h1.y * w; acc8[6] += h1.z * w; acc8[7] += h1.w * w; }
                const int c = n & 511;
                const float dl = fabsf(-3.0701134573f + (float)c * ((-15.3505672866f + 3.0701134573f) / 511.0f));
                u16* g0 = GT + ((size_t)(l * 512 + c) * 2) * GT_STRIDE; u16* g1 = g0 + GT_STRIDE;
#pragma unroll
                for (int pp = 0; pp < 8; ++pp) {
                    const int ii = i0 + pp; const float tt = (float)ii * (1.0f / 2047.0f);
                    float val = acc8[pp] * expf(-tt * dl);
                    int idx;
                    if (n < 512) { idx = 2048 - ii; if (ii == 0) val += P.in[I_HBIAS][l * 512 + c]; } else { idx = 2048 + ii; }
                    if (n < 512 || ii > 0) { const u16 hv = f2bf(val); g0[idx] = hv; g1[idx - 1] = hv; }
                }
            }
            __syncthreads();
        }
    }
}

template <int MODE> DEVI void phase_ln(const float* xin, const u16* mix, const float* gate, float* dst, const float* g, const float* bta, const float* modsh, const float* modsc, u16* H, int wv) {
    int tid_l = wv * 64 + (int)__lane_id(); asm volatile("" : "+v"(tid_l));
    const int lane = tid_l & 63, wave = tid_l >> 6;
    const int gw = blockIdx.x * 8 + wave, NGW = gridDim.x * 8;
    constexpr int R = 8;
    for (int row0 = gw * R; row0 < MTOK; row0 += NGW * R) {
        const int b = row0 >> 11;
        f32x4 v[R][4]; float s[R], s2[R], mean[R], rstd[R];
#pragma unroll
        for (int r = 0; r < R; ++r) { const f32x4* xr = (const f32x4*)(xin + (size_t)(row0 + r) * 1024) + lane;
#pragma unroll
            for (int j = 0; j < 4; ++j) v[r][j] = __builtin_nontemporal_load(xr + 64 * j); }
        if (MODE >= 1) {
            u32x2 mr[R][4];
#pragma unroll
            for (int r = 0; r < R; ++r) { const u32x2* mp = (const u32x2*)(mix + (size_t)(row0 + r) * 1024) + lane;
#pragma unroll
                for (int j = 0; j < 4; ++j) mr[r][j] = __builtin_nontemporal_load(mp + 64 * j); }
            const f32x4* gp = (const f32x4*)(gate + (size_t)b * 6144) + lane;
#pragma unroll
            for (int j = 0; j < 4; ++j) { const f32x4 gv = gp[64 * j] + 1.0f;
#pragma unroll
                for (int r = 0; r < R; ++r) { const f32x4 mv = (f32x4){bflo(mr[r][j].x), bfhi(mr[r][j].x), bflo(mr[r][j].y), bfhi(mr[r][j].y)};
                    v[r][j] = v[r][j] * ALPHA_ + gv * mv; } }
        }
#pragma unroll
        for (int r = 0; r < R; ++r) { s[r] = 0.f;
#pragma unroll
            for (int j = 0; j < 4; ++j) s[r] += (v[r][j].x + v[r][j].y) + (v[r][j].z + v[r][j].w); }
#pragma unroll
        for (int r = 0; r < R; ++r) mean[r] = wave_sum_dpp(s[r]) * (1.f / 1024.f);
#pragma unroll
        for (int r = 0; r < R; ++r) { s2[r] = 0.f;
#pragma unroll
            for (int j = 0; j < 4; ++j) { v[r][j] = v[r][j] - mean[r]; s2[r] += (v[r][j].x * v[r][j].x + v[r][j].y * v[r][j].y) + (v[r][j].z * v[r][j].z + v[r][j].w * v[r][j].w); } }
#pragma unroll
        for (int r = 0; r < R; ++r) rstd[r] = 1.f / sqrtf(wave_sum_dpp(s2[r]) * (1.f / 1024.f) + LN_EPS_);
        if (MODE >= 1) {
#pragma unroll
            for (int j = 0; j < 4; ++j) { const f32x4 gg = *((const f32x4*)g + lane + 64 * j), bb = *((const f32x4*)bta + lane + 64 * j);
#pragma unroll
                for (int r = 0; r < R; ++r) { v[r][j] = v[r][j] * rstd[r] * gg + bb; __builtin_nontemporal_store(v[r][j], (f32x4*)(dst + (size_t)(row0 + r) * 1024) + lane + 64 * j); } }
            if (MODE == 1) {
#pragma unroll
                for (int r = 0; r < R; ++r) { s[r] = 0.f;
#pragma unroll
                    for (int j = 0; j < 4; ++j) s[r] += (v[r][j].x + v[r][j].y) + (v[r][j].z + v[r][j].w); }
#pragma unroll
                for (int r = 0; r < R; ++r) mean[r] = wave_sum_dpp(s[r]) * (1.f / 1024.f);
#pragma unroll
                for (int r = 0; r < R; ++r) { s2[r] = 0.f;
#pragma unroll
                    for (int j = 0; j < 4; ++j) { v[r][j] = v[r][j] - mean[r]; s2[r] += (v[r][j].x * v[r][j].x + v[r][j].y * v[r][j].y) + (v[r][j].z * v[r][j].z + v[r][j].w * v[r][j].w); } }
#pragma unroll
                for (int r = 0; r < R; ++r) rstd[r] = 1.f / sqrtf(wave_sum_dpp(s2[r]) * (1.f / 1024.f) + LN_EPS_);
            }
        }
        if (MODE <= 1) {
            const f32x4* sh = (const f32x4*)(modsh + (size_t)b * 6144) + lane; const f32x4* sc = (const f32x4*)(modsc + (size_t)b * 6144) + lane;
#pragma unroll
            for (int j = 0; j < 4; ++j) { const f32x4 scv = sc[64 * j] + 1.0f, shv = sh[64 * j];
#pragma unroll
                for (int r = 0; r < R; ++r) { const f32x4 y = v[r][j] * rstd[r] * scv + shv;
                    __builtin_nontemporal_store((unsigned long long)pk2(y.x, y.y) | ((unsigned long long)pk2(y.z, y.w) << 32), (unsigned long long*)(H + (size_t)(row0 + r) * 1024) + lane + 64 * j); } }
        }
    }
}

DEVI void phase_hy_prep(const Params& P, int l, LAS unsigned char* lds, int wv) {
    int tid_l = wv * 64 + (int)__lane_id(); asm volatile("" : "+v"(tid_l));
    unsigned char* ws = launder_ws(P.ws); asm volatile("" : "+s"(l));
    const u16* PH = (const u16*)(ws + OFF_PH); u16* UT = (u16*)(ws + OFF_UT); u16* X0 = (u16*)(ws + OFF_X0);
    const int tsub = tid_l >> 6, c8 = (tid_l & 63) * 8;
    for (int item = blockIdx.x; item < 1024; item += gridDim.x) {
        const int b = item >> 5, t0 = (item & 31) * 64 + tsub * 8;
        const u16* base = PH + ((size_t)b * T_ + t0) * 1536 + c8;
        const bool hp = t0 > 0, hn = (t0 + 8) < T_;
        float u[8][8];
#pragma unroll
        for (int i = 0; i < 3; ++i) {
            float w0[8], w1[8], w2[8], bs[8];
            load8f(P.in[I_HCW] + ((size_t)l * 3 + 0) * 1536 + i * 512 + c8, w0); load8f(P.in[I_HCW] + ((size_t)l * 3 + 1) * 1536 + i * 512 + c8, w1);
            load8f(P.in[I_HCW] + ((size_t)l * 3 + 2) * 1536 + i * 512 + c8, w2); load8f(P.in[I_HCB] + (size_t)l * 1536 + i * 512 + c8, bs);
            u32x4 raw[10];
            raw[0] = __builtin_nontemporal_load((const u32x4*)(hp ? base - 1536 + i * 512 : base + i * 512));
#pragma unroll
            for (int r = 0; r < 8; ++r) raw[r + 1] = __builtin_nontemporal_load((const u32x4*)(base + (size_t)r * 1536 + i * 512));
            raw[9] = __builtin_nontemporal_load((const u32x4*)(hn ? base + (size_t)8 * 1536 + i * 512 : base + i * 512));
            float prev[8], cur[8], nxt[8];
            unpack8(raw[0], prev); unpack8(raw[1], cur);
            if (!hp) {
#pragma unroll
                for (int j = 0; j < 8; ++j) prev[j] = 0.f; }
#pragma unroll
            for (int r = 0; r < 8; ++r) {
                unpack8(raw[r + 2], nxt);
                if (r == 7 && !hn) {
#pragma unroll
                    for (int j = 0; j < 8; ++j) nxt[j] = 0.f; }
                float q[8];
#pragma unroll
                for (int j = 0; j < 8; ++j) { q[j] = w0[j] * prev[j] + w1[j] * cur[j] + w2[j] * nxt[j] + bs[j]; prev[j] = cur[j]; cur[j] = nxt[j]; }
                if (i == 0) *(u32x4*)(X0 + ((size_t)b * T_ + t0 + r) * 512 + c8) = pack8(q);
                else if (i == 1) {
#pragma unroll
                    for (int j = 0; j < 8; ++j) u[r][j] = q[j]; }
                else {
#pragma unroll
                    for (int j = 0; j < 8; ++j) u[r][j] *= q[j]; }
            }
        }
#pragma unroll
        for (int j = 0; j < 8; ++j) { const float col[8] = {u[0][j], u[1][j], u[2][j], u[3][j], u[4][j], u[5][j], u[6][j], u[7][j]};
            *(u32x4*)(UT + ((size_t)(c8 + j) * 32 + b) * T_ + t0) = pack8(col); }
    }
}

DEVI void phase_hy_conv(const Params& P, int l, int wv) {
    int tid_l = wv * 64 + (int)__lane_id(); asm volatile("" : "+v"(tid_l));
    unsigned char* ws = launder_ws(P.ws); asm volatile("" : "+s"(l));
    const int lane = tid_l & 63, wave = __builtin_amdgcn_readfirstlane(tid_l >> 6), r = lane & 31, hh = lane >> 5;
    const u16* GT = (const u16*)(ws + OFF_GT); const u16* UT = (const u16*)(ws + OFF_UT); u16* CONVT = (u16*)(ws + OFF_CONVT);
    const int lanebase = 2048 + 8 * hh - r - 256 * wave;
    const int par = lanebase & 1;
    const unsigned goff = (unsigned)((par * GT_STRIDE + lanebase - par) * 2);
    const unsigned uoff = (unsigned)((r * T_ + 8 * hh) * 2), soff = (unsigned)((r * T_ + 4 * hh) * 2);
    for (int c = blockIdx.x; c < 512; c += gridDim.x) {
        const char* gts = (const char*)(GT + ((size_t)(l * 512 + c) * 2) * GT_STRIDE) - 512;
        const char* utb = (const char*)(UT + (size_t)c * 32 * T_);
        f32x16 acc[8];
#pragma unroll
        for (int m = 0; m < 8; ++m)
#pragma unroll
            for (int i = 0; i < 16; ++i) acc[m][i] = 0.f;
        bf16x8 W[16];
#define HY_LOADF(gb_, e16_) (*(const bf16x8_a4*)((gb_) + goff + 32 * (e16_)))
#define HY_LOADB(ub_, j_) (*(const bf16x8*)((ub_) + uoff + 32 * (j_)))
#pragma unroll
        for (int u = 0; u < 16; ++u) W[u] = (bf16x8){0, 0, 0, 0, 0, 0, 0, 0};
#pragma unroll
        for (int u = 2; u < 16; ++u) W[u] = HY_LOADF(gts, u);
        bf16x8 wn0 = HY_LOADF(gts, 16), wn1 = HY_LOADF(gts, 17);
        bf16x8 bn0 = HY_LOADB(utb, 0), bn1 = HY_LOADB(utb, 1);
        for (int jj = 0; jj < 8; ++jj) {
            const char* gj = gts + 512 * jj; const char* uj = utb + 512 * jj;
#pragma unroll
            for (int u = 0; u < 16; ++u) {
                bf16x8 bfr;
                if ((u & 1) == 0) { W[u] = wn0; bfr = bn0; wn0 = HY_LOADF(gj, u + 18); bn0 = HY_LOADB(uj, u + 2); }
                else { W[u] = wn1; bfr = bn1; wn1 = HY_LOADF(gj, u + 18); bn1 = HY_LOADB(uj, u + 2); }
#pragma unroll
                for (int m = 0; m < 8; ++m) acc[m] = __builtin_amdgcn_mfma_f32_32x32x16_bf16(W[(u - 2 * m) & 15], bfr, acc[m], 0, 0, 0);
            }
        }
#undef HY_LOADF
#undef HY_LOADB
        char* cb = (char*)(CONVT + (size_t)c * 32 * T_) + 512 * wave;
#pragma unroll
        for (int m = 0; m < 8; ++m) {
#pragma unroll
            for (int q = 0; q < 4; ++q) { u32x2 o; o.x = pk2(acc[m][4 * q], acc[m][4 * q + 1]); o.y = pk2(acc[m][4 * q + 2], acc[m][4 * q + 3]);
                *(u32x2*)(cb + soff + (64 * m + 16 * q)) = o; } }
    }
}

DEVI void phase_hy_post(const Params& P, LAS unsigned char* lds, int wv) {
    int tid_l = wv * 64 + (int)__lane_id(); asm volatile("" : "+v"(tid_l));
    unsigned char* ws = launder_ws(P.ws);
    const u16* CONVT = (const u16*)(ws + OFF_CONVT); const u16* X0 = (const u16*)(ws + OFF_X0); u16* YM = (u16*)(ws + OFF_A);
    const int tsub = tid_l >> 6, c8 = (tid_l & 63) * 8;
    for (int item = blockIdx.x; item < 1024; item += gridDim.x) {
        const int b = item >> 5, t0 = (item & 31) * 64 + tsub * 8;
        u32x4 cv[8], xv[8];
#pragma unroll
        for (int j = 0; j < 8; ++j) cv[j] = *(const u32x4*)(CONVT + ((size_t)(c8 + j) * 32 + b) * T_ + t0);
#pragma unroll
        for (int r = 0; r < 8; ++r) xv[r] = *(const u32x4*)(X0 + ((size_t)b * T_ + t0 + r) * 512 + c8);
        float cf[8][8];
#pragma unroll
        for (int j = 0; j < 8; ++j) unpack8(cv[j], cf[j]);
#pragma unroll
        for (int r = 0; r < 8; ++r) { float x[8], o[8]; unpack8(xv[r], x);
#pragma unroll
            for (int j = 0; j < 8; ++j) o[j] = x[j] * cf[j][r];
            *(u32x4*)(YM + ((size_t)b * T_ + t0 + r) * 1024 + 512 + c8) = pack8(o); }
    }
}

DEVI void phase_rwkv_prep(const Params& P, int l, int wv) {
    int tid_l = wv * 64 + (int)__lane_id(); asm volatile("" : "+v"(tid_l));
    unsigned char* ws = launder_ws(P.ws); asm volatile("" : "+s"(l));
    const int lane = tid_l & 63, wave = tid_l >> 6, r = lane & 31, hh = lane >> 5;
    const int gw = blockIdx.x * 8 + wave, NGW = gridDim.x * 8;
    const u16* PR = (const u16*)(ws + OFF_PR);
    const u16* LT = (const u16*)(ws + OFF_LT) + (size_t)l * LT_PER_LAYER;
    const float* mup = P.in[I_MUP] + l * 1952; const float* mun = P.in[I_MUN] + l * 1952;
    for (int it = gw; it < 2048 * 5; it += NGW) {
        const int mat = it % 5, tok0 = (it / 5) * 32, tok = tok0 + r, t = tok & 2047;
        const int K = (mat == 4) ? 160 : 64, cbase = (mat == 4) ? 1792 : 1536 + 64 * mat;
        const u16* pr = PR + (size_t)tok * 2048 + cbase + 8 * hh;
        bf16x8 af[10];
#pragma unroll
        for (int kk = 0; kk < 10; ++kk) {
            af[kk] = (bf16x8){0, 0, 0, 0, 0, 0, 0, 0};
            if (kk * 16 < K) {
                float pc[8], pp[8], pn[8], mp[8], mn[8], x[8];
                unpack8(*(const u32x4*)(pr + kk * 16), pc);
                if (t > 0) unpack8(*(const u32x4*)(pr + kk * 16 - 2048), pp); else {
#pragma unroll
                    for (int q = 0; q < 8; ++q) pp[q] = 0.f; }
                if (t < T_ - 1) unpack8(*(const u32x4*)(pr + kk * 16 + 2048), pn); else {
#pragma unroll
                    for (int q = 0; q < 8; ++q) pn[q] = 0.f; }
                load8f(mup + cbase + 8 * hh + kk * 16, mp); load8f(mun + cbase + 8 * hh + kk * 16, mn);
#pragma unroll
                for (int q = 0; q < 8; ++q) { float v = pc[q] + mp[q] * (pp[q] - pc[q]) + mn[q] * (pn[q] - pc[q]);
                    if (mat < 2) v = tanhf_(v); else if (mat == 4) v = sigmoidf_(v);
                    x[q] = v; }
                const u32x4 pk = pack8(x);
                af[kk] = __builtin_bit_cast(bf16x8, pk);
            }
        }
        const u16* lt = (mat < 2) ? LT + (size_t)mat * 32768 : (mat < 4) ? LT + 65536 + (size_t)(mat - 2) * 32768 : LT + 131072;
        const float* bias = (mat < 2) ? P.in[I_W0] + (size_t)(l * 2 + mat) * 512 : P.in[I_A0] + (size_t)(l * 2 + (mat & 1)) * 512;
        u16* outp = (u16*)(ws + (mat == 0 ? OFF_EF : mat == 1 ? OFF_EB : mat == 2 ? OFF_AF : mat == 3 ? OFF_AB : OFF_G));
#define GLOAD16(dst_, ptr_) asm volatile("global_load_dwordx4 %0, %1, off" : "=v"(dst_) : "v"(ptr_) : "memory")
        u32x4 fn[10], fc[10]; f32x4 bn[4], bc[4];
#pragma unroll
        for (int kk = 0; kk < 10; ++kk) { fn[kk] = (u32x4){0u, 0u, 0u, 0u}; fc[kk] = fn[kk]; }
#pragma unroll
        for (int q = 0; q < 4; ++q) { bn[q] = (f32x4){0.f, 0.f, 0.f, 0.f}; bc[q] = bn[q]; }
        { const u16* bp = lt + (size_t)r * K + 8 * hh;
#pragma unroll
          for (int kk = 0; kk < 10; ++kk) if (kk * 16 < K) GLOAD16(fn[kk], bp + kk * 16);
          if (mat < 4) {
#pragma unroll
              for (int q = 0; q < 4; ++q) GLOAD16(bn[q], bias + 8 * q + 4 * hh); } }
        asm volatile("s_waitcnt vmcnt(0)" ::: "memory");
        for (int nt = 0; nt < 16; ++nt) {
#pragma unroll
            for (int kk = 0; kk < 10; ++kk) fc[kk] = fn[kk];
#pragma unroll
            for (int q = 0; q < 4; ++q) bc[q] = bn[q];
            asm volatile("" ::: "memory");
            if (nt + 1 < 16) { const u16* bp = lt + (size_t)((nt + 1) * 32 + r) * K + 8 * hh;
#pragma unroll
                for (int kk = 0; kk < 10; ++kk) if (kk * 16 < K) GLOAD16(fn[kk], bp + kk * 16);
                if (mat < 4) {
#pragma unroll
                    for (int q = 0; q < 4; ++q) GLOAD16(bn[q], bias + (nt + 1) * 32 + 8 * q + 4 * hh); } }
            f32x16 acc;
#pragma unroll
            for (int q = 0; q < 4; ++q)
#pragma unroll
                for (int e = 0; e < 4; ++e) acc[4 * q + e] = bc[q][e] * -1.44269504089f;
#pragma unroll
            for (int kk = 0; kk < 10; ++kk) if (kk * 16 < K) acc = __builtin_amdgcn_mfma_f32_32x32x16_bf16(__builtin_bit_cast(bf16x8, fc[kk]), af[kk], acc, 0, 0, 0);
            unsigned pkd[4][2];
#pragma unroll
            for (int q = 0; q < 4; ++q) {
                float o[4];
#pragma unroll
                for (int e = 0; e < 4; ++e) { const float x = acc[4 * q + e]; o[e] = (mat < 4) ? __builtin_amdgcn_rcpf(1.f + __builtin_amdgcn_exp2f(x)) : x; }
                pkd[q][0] = pk2(o[0], o[1]); pkd[q][1] = pk2(o[2], o[3]);
            }
#pragma unroll
            for (int p = 0; p < 2; ++p) {
                asm volatile("s_nop 1\n\tv_permlane32_swap_b32 %0, %1" : "+v"(pkd[2 * p][0]), "+v"(pkd[2 * p + 1][0]));
                asm volatile("s_nop 1\n\tv_permlane32_swap_b32 %0, %1" : "+v"(pkd[2 * p][1]), "+v"(pkd[2 * p + 1][1]));
                u32x4 w; w.x = pkd[2 * p][0]; w.y = pkd[2 * p][1]; w.z = pkd[2 * p + 1][0]; w.w = pkd[2 * p + 1][1];
                *(u32x4*)(outp + (size_t)(tok0 + r) * 512 + nt * 32 + 16 * p + 8 * hh) = w;
            }
            asm volatile("s_waitcnt vmcnt(2)" ::: "memory");
        }
        asm volatile("s_waitcnt vmcnt(0)" ::: "memory");
#undef GLOAD16
    }
}

DEVI void phase_scan(const Params& P, int l, LAS unsigned char* lds, int wv) {
    int tid_l = wv * 64 + (int)__lane_id(); asm volatile("" : "+v"(tid_l));
    unsigned char* ws = launder_ws(P.ws); asm volatile("" : "+s"(l));
    const int lane = tid_l & 63, wave = __builtin_amdgcn_readfirstlane(tid_l >> 6);
    constexpr int NS = 16, NSET = 2048 / NS, VEC = 6 * 64;
    LAS float* ring = (LAS float*)lds;
    const u16* PR = (const u16*)(ws + OFF_PR);
    const int dir = wave >> 2, rq = wave & 3, jrow = lane & 15;
    for (int bh = blockIdx.x; bh < 256; bh += gridDim.x) {
        const int b = bh >> 3, h = bh & 7, col = h * 64 + lane;
        const u16* prow = PR + (size_t)b * T_ * 2048 + h * 64;
        const float* mup = P.in[I_MUP] + l * 1952; const float* mun = P.in[I_MUN] + l * 1952;
        const float mpr = mup[col], mnr = mun[col], mpk = mup[512 + col], mnk = mun[512 + col], mpv = mup[1024 + col], mnv = mun[1024 + col];
        const float kkw = P.in[I_KK][l * 512 + col], kaw = P.in[I_KA][l * 512 + col];
        const u16* Ep = (const u16*)(ws + (dir ? OFF_EB : OFF_EF)) + (size_t)b * T_ * 512 + h * 64;
        const u16* Ap = (const u16*)(ws + (dir ? OFF_AB : OFF_AF)) + (size_t)b * T_ * 512 + h * 64;
        u16* Yp = (u16*)(ws + (dir ? OFF_YB : OFF_YF)) + (size_t)b * T_ * 512 + h * 64 + 16 * rq + 2 * (lane >> 3);
        f32x2 S2[2][4];
#pragma unroll
        for (int i = 0; i < 2; ++i)
#pragma unroll
            for (int c = 0; c < 4; ++c) S2[i][c] = (f32x2){0.f, 0.f};
        const float mAr = dir ? mnr : mpr, mBr = dir ? mpr : mnr, mAk = dir ? mnk : mpk, mBk = dir ? mpk : mnk, mAv = dir ? mnv : mpv, mBv = dir ? mpv : mnv;
        unsigned rwr[6][3], rwe[4], rwa[4];
#define SCAN_ISSUE(set_) do { const int s0_ = (set_) * NS + 4 * rq; \
            _Pragma("unroll") for (int ix = 0; ix < 6; ++ix) { int pos = s0_ - 1 + ix; pos = pos < 0 ? 0 : (pos > 2047 ? 2047 : pos); const int tm = dir ? 2047 - pos : pos; \
                const u16* pc = prow + (size_t)tm * 2048; rwr[ix][0] = pc[lane]; rwr[ix][1] = pc[512 + lane]; rwr[ix][2] = pc[1024 + lane]; } \
            _Pragma("unroll") for (int q = 0; q < 4; ++q) { const int pos = s0_ + q; const int tm = dir ? 2047 - pos : pos; \
                rwe[q] = Ep[(size_t)tm * 512 + lane]; rwa[q] = Ap[(size_t)tm * 512 + lane]; } } while (0)
#define SCAN_PRODUCE(set_) do { const int s0_ = (set_) * NS + 4 * rq; \
            _Pragma("unroll") for (int q = 0; q < 4; ++q) { \
            const int st = 4 * rq + q, pos = s0_ + q; \
            const float fA = pos > 0 ? 1.f : 0.f, fB = pos < 2047 ? 1.f : 0.f; \
            const float c0 = bf2f(rwr[q + 1][0]), c1 = bf2f(rwr[q + 1][1]), c2 = bf2f(rwr[q + 1][2]); \
            const float r_ = c0 + mAr * (fA * bf2f(rwr[q][0]) - c0) + mBr * (fB * bf2f(rwr[q + 2][0]) - c0); \
            const float k_ = c1 + mAk * (fA * bf2f(rwr[q][1]) - c1) + mBk * (fB * bf2f(rwr[q + 2][1]) - c1); \
            const float v_ = c2 + mAv * (fA * bf2f(rwr[q][2]) - c2) + mBv * (fB * bf2f(rwr[q + 2][2]) - c2); \
            const float kkv = k_ * kkw; const float ss = wave_sum_dpp(kkv * kkv); \
            const float kkn = kkv * __builtin_amdgcn_rsqf(fmaxf(ss, 1e-24f)); \
            const float a_ = bf2f(rwa[q]), w_ = __builtin_amdgcn_exp2f(bf2f(rwe[q]) * (-0.60653065971f * 1.44269504089f)); \
            LAS float* o = ring + ((((set_) & 1) * 2 + dir) * NS + st) * VEC + lane; \
            o[0] = -kkn; o[64] = w_; o[128] = kkn * a_; o[192] = k_ * (1.f + (a_ - 1.f) * kaw); o[256] = r_; o[320] = v_; } } while (0)
        SCAN_ISSUE(0);
        SCAN_PRODUCE(0);
        SCAN_ISSUE(1);
        __syncthreads();
        for (int set = 0; set < NSET; ++set) {
            if (set + 1 < NSET) SCAN_PRODUCE(set + 1);
            if (set + 2 < NSET) SCAN_ISSUE(set + 2);
            const LAS float* sb = ring + ((set & 1) * 2 + dir) * NS * VEC + 8 * (lane & 7);
            const int voff = 320 + 16 * rq + 2 * (lane >> 3) - 8 * (lane & 7);
#pragma unroll 2
            for (int st = 0; st < NS; ++st) {
                const LAS float* sm = sb + st * VEC;
                const f32x2 vv = *(const LAS f32x2*)(sm + voff);
                const f32x4 z0 = *(const LAS f32x4*)(sm), z1 = *(const LAS f32x4*)(sm + 4), w0 = *(const LAS f32x4*)(sm + 64), w1 = *(const LAS f32x4*)(sm + 68),
                            b0 = *(const LAS f32x4*)(sm + 128), b1 = *(const LAS f32x4*)(sm + 132), d0 = *(const LAS f32x4*)(sm + 192), d1 = *(const LAS f32x4*)(sm + 196),
                            r0 = *(const LAS f32x4*)(sm + 256), r1 = *(const LAS f32x4*)(sm + 260);
                const f32x2 zp[4] = {(f32x2){z0.x, z0.y}, (f32x2){z0.z, z0.w}, (f32x2){z1.x, z1.y}, (f32x2){z1.z, z1.w}};
                const f32x2 wp[4] = {(f32x2){w0.x, w0.y}, (f32x2){w0.z, w0.w}, (f32x2){w1.x, w1.y}, (f32x2){w1.z, w1.w}};
                const f32x2 bp[4] = {(f32x2){b0.x, b0.y}, (f32x2){b0.z, b0.w}, (f32x2){b1.x, b1.y}, (f32x2){b1.z, b1.w}};
                const f32x2 dp[4] = {(f32x2){d0.x, d0.y}, (f32x2){d0.z, d0.w}, (f32x2){d1.x, d1.y}, (f32x2){d1.z, d1.w}};
                const f32x2 rp[4] = {(f32x2){r0.x, r0.y}, (f32x2){r0.z, r0.w}, (f32x2){r1.x, r1.y}, (f32x2){r1.z, r1.w}};
                f32x2 sA = S2[0][0] * zp[0] + S2[0][1] * zp[1], sB = S2[0][2] * zp[2] + S2[0][3] * zp[3];
                f32x2 sC = S2[1][0] * zp[0] + S2[1][1] * zp[1], sD = S2[1][2] * zp[2] + S2[1][3] * zp[3];
                const f32x2 s0v = sA + sB, s1v = sC + sD;
                float sz0 = s0v.x + s0v.y, sz1 = s1v.x + s1v.y; red8x2(sz0, sz1);
                const f32x2 z0v = (f32x2){sz0, sz0}, z1v = (f32x2){sz1, sz1}, vxv = (f32x2){vv.x, vv.x}, vyv = (f32x2){vv.y, vv.y};
                f32x2 yA = (f32x2){0.f, 0.f}, yB = yA;
#pragma unroll
                for (int c = 0; c < 4; ++c) {
                    S2[0][c] = S2[0][c] * wp[c] + z0v * bp[c] + vxv * dp[c]; yA += S2[0][c] * rp[c];
                    S2[1][c] = S2[1][c] * wp[c] + z1v * bp[c] + vyv * dp[c]; yB += S2[1][c] * rp[c];
                }
                const float ya0 = yA.x, yb0 = yA.y, ya1 = yB.x, yb1 = yB.y;
                float y0 = ya0 + yb0, y1 = ya1 + yb1; red8x2(y0, y1);
                const int s_ = set * NS + st, tm = dir ? 2047 - s_ : s_;
                if ((lane & 7) == 0) *(unsigned*)(Yp + (size_t)tm * 512) = pk2(y0, y1);
            }
            LDS_WAIT(); __builtin_amdgcn_s_barrier();
        }
#undef SCAN_ISSUE
#undef SCAN_PRODUCE
    }
}

DEVI void phase_rwkv_post(const Params& P, int l, int wv) {
    int tid_l = wv * 64 + (int)__lane_id(); asm volatile("" : "+v"(tid_l));
    unsigned char* ws = launder_ws(P.ws); asm volatile("" : "+s"(l));
    const int lane = tid_l & 63, wave = tid_l >> 6;
    const int gw = blockIdx.x * 8 + wave, NGW = gridDim.x * 8;
    const int ch0 = lane * 8;
    const u16* PR = (const u16*)(ws + OFF_PR); const u16* AF = (const u16*)(ws + OFF_AF); const u16* AB = (const u16*)(ws + OFF_AB);
    const u16* G = (const u16*)(ws + OFF_G); const u16* YF = (const u16*)(ws + OFF_YF); const u16* YB = (const u16*)(ws + OFF_YB);
    u16* YM = (u16*)(ws + OFF_A);
    float mp[3][8], mn[3][8], ka[8], gw_[8], gb_[8], rk[8];
#pragma unroll
    for (int i = 0; i < 3; ++i) { load8f(P.in[I_MUP] + l * 1952 + i * 512 + ch0, mp[i]); load8f(P.in[I_MUN] + l * 1952 + i * 512 + ch0, mn[i]); }
    load8f(P.in[I_KA] + l * 512 + ch0, ka); load8f(P.in[I_GNW] + l * 512 + ch0, gw_); load8f(P.in[I_GNB] + l * 512 + ch0, gb_); load8f(P.in[I_RK] + l * 512 + ch0, rk);
    u32x4 cu[14], nx[14];
#define RP_LOAD(D_, tok_) do { const int t_ = (tok_) & 2047; const u16* q_ = PR + (size_t)(tok_) * 2048 + ch0; \
        _Pragma("unroll") for (int i = 0; i < 3; ++i) { D_[3 * i] = *(const u32x4*)(q_ + i * 512); D_[3 * i + 1] = *(const u32x4*)(q_ + i * 512 - (t_ > 0 ? 2048 : 0)); D_[3 * i + 2] = *(const u32x4*)(q_ + i * 512 + (t_ < T_ - 1 ? 2048 : 0)); } \
        D_[9] = *(const u32x4*)(AF + (size_t)(tok_) * 512 + ch0); D_[10] = *(const u32x4*)(AB + (size_t)(tok_) * 512 + ch0); D_[11] = *(const u32x4*)(G + (size_t)(tok_) * 512 + ch0); \
        D_[12] = *(const u32x4*)(YF + (size_t)(tok_) * 512 + ch0); D_[13] = *(const u32x4*)(YB + (size_t)(tok_) * 512 + ch0); } while (0)
    if (gw < MTOK) RP_LOAD(cu, gw);
    for (int tok = gw; tok < MTOK; tok += NGW) {
        const int t = tok & 2047;
        const int tn = tok + NGW < MTOK ? tok + NGW : tok;
        RP_LOAD(nx, tn);
        const float fp = t > 0 ? 1.f : 0.f, fn = t < T_ - 1 ? 1.f : 0.f;
        float x[3][8];
#pragma unroll
        for (int i = 0; i < 3; ++i) { float pc[8], pp[8], pn[8]; unpack8(cu[3 * i], pc); unpack8(cu[3 * i + 1], pp); unpack8(cu[3 * i + 2], pn);
#pragma unroll
            for (int j = 0; j < 8; ++j) x[i][j] = pc[j] + mp[i][j] * (fp * pp[j] - pc[j]) + mn[i][j] * (fn * pn[j] - pc[j]); }
        float af[8], ab[8], g[8], yf[8], yb[8], y[8];
        unpack8(cu[9], af); unpack8(cu[10], ab); unpack8(cu[11], g); unpack8(cu[12], yf); unpack8(cu[13], yb);
        float s = 0.f;
#pragma unroll
        for (int j = 0; j < 8; ++j) { y[j] = yf[j] + yb[j]; s += y[j]; }
        const float mean = red8(s) * (1.f / 64.f); float s2 = 0.f, bs = 0.f;
#pragma unroll
        for (int j = 0; j < 8; ++j) { y[j] -= mean; s2 += y[j] * y[j];
            const float ks = x[1][j] * (2.f + (af[j] + ab[j] - 2.f) * ka[j]); bs += x[0][j] * ks * rk[j]; }
        const float rstd = __builtin_amdgcn_rsqf(red8(s2) * (1.f / 64.f) + GN_EPS_);
        bs = red8(bs);
        float o[8];
#pragma unroll
        for (int j = 0; j < 8; ++j) o[j] = (y[j] * rstd * gw_[j] + gb_[j] + bs * x[2][j]) * g[j];
        *(u32x4*)(YM + (size_t)tok * 1024 + ch0) = pack8(o);
#pragma unroll
        for (int i = 0; i < 14; ++i) cu[i] = nx[i];
    }
#undef RP_LOAD
}

DEVI void phase_act(const Params& P, int l, size_t dst_off, int wrap_mask, int wv) {
    int tid_l = wv * 64 + (int)__lane_id(); asm volatile("" : "+v"(tid_l));
    unsigned char* ws = launder_ws(P.ws); asm volatile("" : "+s"(l));
    const int gtid = blockIdx.x * 512 + tid_l, NT = gridDim.x * 512;
    u16* UA = (u16*)(ws + OFF_UA); const u16* UG = (const u16*)(ws + OFF_UG); u16* UD = (u16*)(ws + dst_off);
    for (int idx = gtid; idx < 8192 * 352; idx += NT) {
        const int chunk = idx / 352, cg8 = (idx % 352) * 8, tok0 = chunk * 8, t0 = tok0 & 2047;
        float w0[8], w1[8], w2[8], bs[8];
        load8f(P.in[I_FCW] + ((size_t)l * 3 + 0) * 2816 + cg8, w0); load8f(P.in[I_FCW] + ((size_t)l * 3 + 1) * 2816 + cg8, w1);
        load8f(P.in[I_FCW] + ((size_t)l * 3 + 2) * 2816 + cg8, w2); load8f(P.in[I_FCB] + (size_t)l * 2816 + cg8, bs);
        const u16* ug = UG + (size_t)tok0 * 2816 + cg8; const u16* ua = UA + (size_t)tok0 * 2816 + cg8;
        u32x4 gr[10], ar[8];
        const bool hp = t0 > 0, hn = (t0 + 8) < T_;
        gr[0] = *(const u32x4*)(hp ? ug - 2816 : ug);
#pragma unroll
        for (int i = 0; i < 8; ++i) { gr[i + 1] = *(const u32x4*)(ug + (size_t)i * 2816); ar[i] = *(const u32x4*)(ua + (size_t)i * 2816); }
        gr[9] = *(const u32x4*)(hn ? ug + (size_t)8 * 2816 : ug);
        if (!hp) gr[0] = (u32x4){0u, 0u, 0u, 0u};
        if (!hn) gr[9] = (u32x4){0u, 0u, 0u, 0u};
        float prev[8], cur[8], nxt[8];
        unpack8(gr[0], prev); unpack8(gr[1], cur);
#pragma unroll
        for (int i = 0; i < 8; ++i) {
            unpack8(gr[i + 2], nxt);
            float a[8], o[8]; unpack8(ar[i], a);
#pragma unroll
            for (int j = 0; j < 8; j += 2) {
                f32x2 u = (f32x2){w0[j] * prev[j] + w1[j] * cur[j] + w2[j] * nxt[j] + bs[j], w0[j + 1] * prev[j + 1] + w1[j + 1] * cur[j + 1] + w2[j + 1] * nxt[j + 1] + bs[j + 1]};
                const f32x2 gl = pg8::gelu_pk(u); o[j] = gl.x * a[j]; o[j + 1] = gl.y * a[j + 1]; }
            *(u32x4*)(UD + (size_t)((tok0 + i) & wrap_mask) * 2816 + cg8) = pack8(o);
#pragma unroll
            for (int j = 0; j < 8; ++j) { prev[j] = cur[j]; cur[j] = nxt[j]; }
        }
    }
}

#define LAUNDER_WS() unsigned char* ws = launder_ws(P.ws); asm volatile("" : "+s"(l)); float* MOD = (float*)(ws + OFF_MOD); u16* HA = (u16*)(ws + OFF_A); const float* modl = MOD + (size_t)l * 32 * 6144; (void)modl; (void)HA
#ifndef DUP
#define DUP 0
#endif
#define REP(mask_) for (int rep_ = 0; rep_ < ((DUP & (mask_)) ? 2 : 1); ++rep_)
__global__ void __launch_bounds__(512, 2) mega_fwd(Params P) {
    extern __shared__ __attribute__((aligned(16))) unsigned char smem_[];
    LAS unsigned char* lds = (LAS unsigned char*)smem_;
    cg::grid_group grid = cg::this_grid();
    const int wv = __builtin_amdgcn_readfirstlane((int)threadIdx.x >> 6);
    volatile LAS unsigned* xst = (volatile LAS unsigned*)(lds + 131072);
    if (wv == 0 && __lane_id() == 0) { xst[0] = 0u; xst[1] = 0u; xst[2] = 0u; xst[3] = 0u; }
    __syncthreads();
    if (wv == 0 && __lane_id() == 0) (void)xb_add(&((unsigned*)P.ws)[XB_XCNT(xb_xcc_id())], 1u);
#define GSYNC() do { XcdBarrier b_; b_.bar = (unsigned*)launder_ws(P.ws); b_.x = xb_xcc_id(); b_.st = (volatile LAS unsigned*)(lds + 131072); xcd_barrier(b_, wv == 0 && __lane_id() == 0); } while (0)
    REP(16) phase_prologue(P, lds, wv);
    grid.sync();
    if (DUP & 32) { for (int i = 0; i < 20; ++i) GSYNC(); }
    REP(16) { int l = 0; LAUNDER_WS(); phase_ln<0>(P.in[I_X], nullptr, nullptr, nullptr, nullptr, nullptr, MOD + 0 * 1024, MOD + 1 * 1024, HA, wv); }
    GSYNC();
#pragma nounroll
    for (int l = 0; l < 2; ++l) {
        REP(1) { LAUNDER_WS(); EpiSplitBf16 E; E.O0 = (u16*)(ws + OFF_PR); E.O1 = (u16*)(ws + OFF_PH); E.nsplit = 8; E.ld0 = 2048; E.ld1 = 1536;
          run_gemm(lds, HA, (const u16*)(ws + OFF_WINT) + (size_t)l * 3584 * 1024, 3584, 1024, E, wv); }
        GSYNC();
        REP(4) phase_hy_prep(P, l, lds, wv);
        GSYNC();
        REP(4 | 64) phase_hy_conv(P, l, wv);
        GSYNC();
        REP(4) phase_hy_post(P, lds, wv);
        GSYNC();
        REP(8 | 128) phase_rwkv_prep(P, l, wv);
        GSYNC();
        REP(2) phase_scan(P, l, lds, wv);
        GSYNC();
        REP(8) phase_rwkv_post(P, l, wv);
        GSYNC();
        { LAUNDER_WS(); EpiSplitBf16 E; E.O0 = (u16*)(ws + OFF_B); E.O1 = E.O0; E.nsplit = 4; E.ld0 = 1024; E.ld1 = 1024;
          run_gemm(lds, HA, (const u16*)(ws + OFF_WOT) + (size_t)l * 1024 * 1024, 1024, 1024, E, wv); }
        GSYNC();
        { LAUNDER_WS(); phase_ln<1>((l == 0) ? P.in[I_X] : P.out, (const u16*)(ws + OFF_B), modl + 2 * 1024, P.out, P.in[I_LMG] + l * 1024, P.in[I_LMB] + l * 1024, modl + 3 * 1024, modl + 4 * 1024, HA, wv); }
        GSYNC();
        REP(1) { LAUNDER_WS(); EpiSplitBf16 E; E.O0 = (u16*)(ws + OFF_UA); E.O1 = (u16*)(ws + OFF_UG); E.nsplit = 11; E.ld0 = 2816; E.ld1 = 2816;
          run_gemm(lds, HA, (const u16*)(ws + OFF_WUT) + (size_t)l * 5632 * 1024, 5632, 1024, E, wv); }
        GSYNC();
        if (DUP & 512) phase_act(P, l, OFF_B + 704 * MiB, 16383, wv);
        phase_act(P, l, OFF_UA, 0x7fffffff, wv);
        GSYNC();
        { LAUNDER_WS(); EpiSplitBf16 E; E.O0 = HA; E.O1 = HA; E.nsplit = 4; E.ld0 = 1024; E.ld1 = 1024;
          run_gemm(lds, (const u16*)(ws + OFF_UA), (const u16*)(ws + OFF_WDT) + (size_t)l * 1024 * 2816, 1024, 2816, E, wv); }
        GSYNC();
        { LAUNDER_WS();
          if (l == 0) phase_ln<1>(P.out, HA, modl + 5 * 1024, P.out, P.in[I_LFG], P.in[I_LFB], MOD + (size_t)32 * 6144 + 0 * 1024, MOD + (size_t)32 * 6144 + 1 * 1024, HA, wv);
          else phase_ln<2>(P.out, HA, modl + 5 * 1024, P.out, P.in[I_LFG] + 1024, P.in[I_LFB] + 1024, nullptr, nullptr, nullptr, wv); }
        if (l == 0) GSYNC();
    }
#undef GSYNC
}

extern "C" void kernel_launch(void* const* d_in, const int* in_sizes, int n_in, void* d_out, int out_size, void* d_ws, size_t ws_size, hipStream_t stream) {
    static int grid = 0;
    constexpr int LDS_BYTES = 131072 + 16;
    if (grid == 0) {
        if (n_in != 36 || out_size != MTOK * 1024 || ws_size < WS_NEED) { fprintf(stderr, "kernel_launch: unexpected shapes (n_in %d out %d ws %zu)\n", n_in, out_size, ws_size); grid = -1; return; }
        int dev = 0, cus = 0, per_cu = 0;
        hipGetDevice(&dev); hipDeviceGetAttribute(&cus, hipDeviceAttributeMultiprocessorCount, dev);
        hipFuncSetAttribute((const void*)mega_fwd, hipFuncAttributeMaxDynamicSharedMemorySize, LDS_BYTES);
        hipOccupancyMaxActiveBlocksPerMultiprocessor(&per_cu, (const void*)mega_fwd, 512, LDS_BYTES);
        if (per_cu < 1) { fprintf(stderr, "kernel_launch: occupancy query says %d blocks/CU\n", per_cu); per_cu = 1; }
        grid = cus;
        (void)hipGetLastError();
    }
    if (grid < 0) return;
    if (hipMemsetAsync(d_ws, 0, 16384, stream) != hipSuccess) { fprintf(stderr, "kernel_launch: memset of the barrier words failed\n"); return; }
    Params p{};
    for (int i = 0; i < 36; ++i) p.in[i] = (const float*)d_in[i];
    p.out = (float*)d_out; p.ws = (unsigned char*)d_ws;
    void* args[] = {&p};
    hipError_t e = hipLaunchCooperativeKernel((const void*)mega_fwd, dim3(grid), dim3(512), args, LDS_BYTES, stream);
    if (e != hipSuccess) fprintf(stderr, "cooperative launch failed: %s (grid %d)\n", hipGetErrorString(e), grid);
}
```
